# Optimizing an MI355X kernel written in HIP

```python
import jax, jax.numpy as jnp
from jax import lax
import numpy as np

D_MODEL = 1024
BATCH = 32
SEQ = 2048
DEPTH = 1
DEC_BATCH = 2
DEC_SEQ = 8192
PAST_LEN = 128

GRID_W = 64
HEAD_DIM = 64
N_HEADS_A = 8
N_KV_HEADS_A = 2
N_HEADS_B = 8
WIDTH_A = N_HEADS_A * HEAD_DIM
WIDTH_KV_A = N_KV_HEADS_A * HEAD_DIM
WIDTH_B = N_HEADS_B * HEAD_DIM
NA_MAX_ROWS = 8
NA_COLS = 16
Q_BLOCK = 128
ROPE_THETA = 10000.0
D_FF = 2816
CONV_WIDTH = 3
EPS = 1e-6
SPLIT_SIZES = [WIDTH_A, WIDTH_KV_A, WIDTH_KV_A, WIDTH_B, WIDTH_B, WIDTH_B, D_MODEL, D_MODEL]
D_IN = sum(SPLIT_SIZES)
SPLIT_POINTS = [int(v) for v in np.cumsum(SPLIT_SIZES)[:-1]]

kernel_name = "hybrid_gqa_natten_gated_encoder"


def rms_norm(x, w):
    xf = x.astype(jnp.float32)
    y = xf * lax.rsqrt(jnp.mean(xf * xf, axis=-1, keepdims=True) + EPS)
    return (y * w.astype(jnp.float32)).astype(x.dtype)


def axial_rope_tables(seq_len, dtype):
    t = np.arange(seq_len)
    row = (t // GRID_W).astype(np.float32)
    col = (t % GRID_W).astype(np.float32)
    half = HEAD_DIM // 2
    freqs = (ROPE_THETA ** (-np.arange(0, half, 2, dtype=np.float32) / half)).astype(np.float32)
    ang_r = row[:, None] * freqs[None, :]
    ang_c = col[:, None] * freqs[None, :]
    ang = np.concatenate([ang_r, ang_r, ang_c, ang_c], axis=-1).astype(np.float32)
    return jnp.asarray(np.cos(ang), dtype), jnp.asarray(np.sin(ang), dtype)


def rotate_half(x):
    h = x.shape[-1] // 2
    return jnp.concatenate([-x[..., h:], x[..., :h]], axis=-1)


def apply_axial_rope(x, cos, sin):
    half = HEAD_DIM // 2
    rot = jnp.concatenate([rotate_half(x[..., :half]), rotate_half(x[..., half:])], axis=-1)
    return x * cos[:, None, :] + rot * sin[:, None, :]


def gqa_branch(q, k, v, q_norm_w, k_norm_w):
    B, S = q.shape[:2]
    G = N_HEADS_A // N_KV_HEADS_A
    q = rms_norm(q.reshape(B, S, N_HEADS_A, HEAD_DIM), q_norm_w)
    k = rms_norm(k.reshape(B, S, N_KV_HEADS_A, HEAD_DIM), k_norm_w)
    v = v.reshape(B, S, N_KV_HEADS_A, HEAD_DIM)
    cos, sin = axial_rope_tables(S, q.dtype)
    q = apply_axial_rope(q, cos, sin)
    k = apply_axial_rope(k, cos, sin)
    n_blocks = S // Q_BLOCK
    qb = q.reshape(B, n_blocks, Q_BLOCK, N_KV_HEADS_A, G, HEAD_DIM).transpose(1, 0, 2, 3, 4, 5)
    scale = HEAD_DIM ** -0.5

    def attend_block(q_blk):
        s = jnp.einsum('bqkgd,bskd->bkgqs', q_blk, k).astype(jnp.float32) * scale
        p = jax.nn.softmax(s, axis=-1).astype(v.dtype)
        return jnp.einsum('bkgqs,bskd->bqkgd', p, v)

    o = lax.map(attend_block, qb)
    return o.transpose(1, 0, 2, 3, 4, 5).reshape(B, S, WIDTH_A)


def neighbourhood_branch(q, k, v, rpb):
    B, S = q.shape[:2]
    rows = S // GRID_W
    wr = min(NA_MAX_ROWS, rows)
    qg = q.reshape(B, rows, GRID_W, N_HEADS_B, HEAD_DIM).transpose(1, 0, 2, 3, 4)
    kg = k.reshape(B, rows, GRID_W, N_HEADS_B, HEAD_DIM)
    vg = v.reshape(B, rows, GRID_W, N_HEADS_B, HEAD_DIM)
    r = np.arange(rows)
    row_start = np.clip(r - wr // 2, 0, rows - wr).astype(np.int32)
    row_off_idx = (row_start[:, None] + np.arange(wr)[None, :] - r[:, None] + NA_MAX_ROWS - 1).astype(np.int32)
    c = np.arange(GRID_W)
    col_start = np.clip(c - NA_COLS // 2, 0, GRID_W - NA_COLS)
    in_win = (c[None, :] >= col_start[:, None]) & (c[None, :] < col_start[:, None] + NA_COLS)
    col_idx = np.clip(c[None, :] - c[:, None], -(NA_COLS - 1), NA_COLS - 1) + NA_COLS - 1
    col_mask = jnp.asarray(in_win)
    rpb_cols = rpb[:, :, col_idx]
    scale = HEAD_DIM ** -0.5

    def row_block(args):
        q_row, start, off_idx = args
        k_band = lax.dynamic_slice_in_dim(kg, start, wr, axis=1)
        v_band = lax.dynamic_slice_in_dim(vg, start, wr, axis=1)
        s = jnp.einsum('bqhd,bwkhd->bhqwk', q_row, k_band).astype(jnp.float32) * scale
        bias = jnp.take(rpb_cols, off_idx, axis=1).transpose(0, 2, 1, 3)
        s = s + bias.astype(jnp.float32)[None]
        s = jnp.where(col_mask[None, None, :, None, :], s, -jnp.inf)
        p = jax.nn.softmax(s, axis=(-2, -1)).astype(v_band.dtype)
        return jnp.einsum('bhqwk,bwkhd->bqhd', p, v_band)

    o = lax.map(row_block, (qg, jnp.asarray(row_start), jnp.asarray(row_off_idx)))
    return o.transpose(1, 0, 2, 3, 4).reshape(B, S, WIDTH_B)


def depthwise_conv_centred(u, w, b):
    pad = CONV_WIDTH // 2
    S = u.shape[1]
    up = jnp.pad(u, ((0, 0), (pad, pad), (0, 0)))
    out = up[:, 0:S] * w[0] + b
    for j in range(1, CONV_WIDTH):
        out = out + up[:, j:j + S] * w[j]
    return out


def encoder_layer(x, pre_mix_norm, w_in, b_gate, q_norm, k_norm, rpb, w_proj_a, w_proj_b, w_out,
                  post_mix_norm, pre_ffn_norm, w_up, conv_w, conv_b, w_down, post_ffn_norm):
    h = rms_norm(x, pre_mix_norm)
    proj = h @ w_in
    qa, ka, va, qb, kb, vb, g_a, g_b = jnp.split(proj, SPLIT_POINTS, axis=-1)
    gate_a = jax.nn.sigmoid((g_a + b_gate[:D_MODEL]).astype(jnp.float32)).astype(x.dtype)
    gate_b = jax.nn.sigmoid((g_b + b_gate[D_MODEL:]).astype(jnp.float32)).astype(x.dtype)
    o_a = gqa_branch(qa, ka, va, q_norm, k_norm) @ w_proj_a
    o_b = neighbourhood_branch(qb, kb, vb, rpb) @ w_proj_b
    mix = (gate_a * o_a + gate_b * o_b) @ w_out
    x = x + rms_norm(mix, post_mix_norm)
    h = rms_norm(x, pre_ffn_norm)
    u = depthwise_conv_centred(h @ w_up, conv_w, conv_b)
    gate, val = u[..., :D_FF], u[..., D_FF:]
    f = (jax.nn.gelu(gate, approximate=True) * val) @ w_down
    return x + rms_norm(f, post_ffn_norm)


def setup_inputs(seed: int = 0) -> dict:
    key = jax.random.key(seed)
    ks = jax.random.split(key, 20)
    f32 = jnp.float32

    def nrm(k, shape, scale):
        return jax.random.normal(k, shape, f32) * scale

    def gain(k, shape):
        return 1.0 + 0.01 * jax.random.normal(k, shape, f32)

    return {
        "x_prompt": nrm(ks[0], (BATCH, SEQ, D_MODEL), 1.0),
        "x_sample": nrm(ks[1], (DEC_BATCH, DEC_SEQ, D_MODEL), 1.0),
        "pre_mix_norm": gain(ks[2], (DEPTH, D_MODEL)),
        "w_in": nrm(ks[3], (DEPTH, D_MODEL, D_IN), D_MODEL ** -0.5),
        "b_gate": nrm(ks[4], (DEPTH, 2 * D_MODEL), 0.01),
        "q_norm": gain(ks[5], (DEPTH, HEAD_DIM)),
        "k_norm": gain(ks[6], (DEPTH, HEAD_DIM)),
        "rpb": nrm(ks[7], (DEPTH, N_HEADS_B, 2 * NA_MAX_ROWS - 1, 2 * NA_COLS - 1), 0.02),
        "w_proj_a": nrm(ks[8], (DEPTH, WIDTH_A, D_MODEL), WIDTH_A ** -0.5),
        "w_proj_b": nrm(ks[9], (DEPTH, WIDTH_B, D_MODEL), WIDTH_B ** -0.5),
        "w_out": nrm(ks[10], (DEPTH, D_MODEL, D_MODEL), D_MODEL ** -0.5),
        "post_mix_norm": gain(ks[11], (DEPTH, D_MODEL)),
        "pre_ffn_norm": gain(ks[12], (DEPTH, D_MODEL)),
        "w_up": nrm(ks[13], (DEPTH, D_MODEL, 2 * D_FF), D_MODEL ** -0.5),
        "conv_w": nrm(ks[14], (DEPTH, CONV_WIDTH, 2 * D_FF), CONV_WIDTH ** -0.5),
        "conv_b": nrm(ks[15], (DEPTH, 2 * D_FF), 0.01),
        "w_down": nrm(ks[16], (DEPTH, D_FF, D_MODEL), D_FF ** -0.5),
        "post_ffn_norm": gain(ks[17], (DEPTH, D_MODEL)),
    }


def reference(x_prompt, x_sample, pre_mix_norm, w_in, b_gate, q_norm, k_norm, rpb, w_proj_a, w_proj_b,
              w_out, post_mix_norm, pre_ffn_norm, w_up, conv_w, conv_b, w_down, post_ffn_norm):
    def run_trunk(x):
        for l in range(DEPTH):
            x = encoder_layer(x, pre_mix_norm[l], w_in[l], b_gate[l], q_norm[l], k_norm[l], rpb[l],
                              w_proj_a[l], w_proj_b[l], w_out[l], post_mix_norm[l], pre_ffn_norm[l],
                              w_up[l], conv_w[l], conv_b[l], w_down[l], post_ffn_norm[l])
        return x

    y_prompt = run_trunk(x_prompt)
    y_sample = run_trunk(x_sample)
    return (y_prompt, y_sample)
```

```cpp
#include <hip/hip_runtime.h>
#include <hip/hip_cooperative_groups.h>
#include <hip/hip_bf16.h>
#include <cstdio>
#include <cstdint>
#include <cmath>
namespace cg = cooperative_groups;
namespace pg8 {
#define PG8_LAS __attribute__((address_space(3)))
typedef unsigned short bf16_t;
typedef short bf16x8 __attribute__((ext_vector_type(8)));
typedef float f32x4 __attribute__((ext_vector_type(4)));
typedef unsigned u32x4 __attribute__((ext_vector_type(4)));
constexpr int BM = 256, BK = 64, HALF = 128, HTB = HALF * BK * 2  , STAGE_BYTES = 8 * HTB, NXCD = 8, WGM = 8;

__host__ __device__ __forceinline__ int lds_byte(int r, int c) { const int st = (r >> 4) * 2 + (c >> 5), rr = r & 15, cc = c & 31, ob = rr * 64 + cc * 2; return st * 1024 + (ob ^ (((ob >> 9) & 1) << 5)); }
__host__ __device__ __forceinline__ void stage_rc(int b, int& R, int& C) { const int st = b / 1024, sb = b % 1024, swz = sb ^ (((sb >> 9) & 1) << 5); R = (st >> 1) * 16 + swz / 64; C = (st & 1) * 32 + (swz % 64) / 2; }
__host__ __device__ __forceinline__ int perm32(int rho) { const int n = rho >> 4, i = rho & 15; return 8 * (i >> 2) + 4 * n + (i & 3); }

struct Unit { int pm, pn, ko; };
struct Gemm { const bf16_t* A; const bf16_t* Bt; int M, N, K, lda, ldb; };

struct StaticOrder {
    int nM, nN, nwg, G, c;
    __host__ __device__ void init(int M, int N, int G_, int c_) { nM = M / BM; nN = N / BM; nwg = nM * nN; G = G_; c = c_; }
    __host__ __device__ bool next(int i, Unit& u) const {
        const long L = (long)i * G + c; if (L >= nwg) return false;
        int wgid = (int)L; { const int q = nwg / NXCD, r = nwg % NXCD, xcd = wgid % NXCD, off = wgid / NXCD; wgid = (xcd < r ? xcd * (q + 1) : r * (q + 1) + (xcd - r) * q) + off; }
        const int nig = WGM * nN, gid = wgid / nig, fm = gid * WGM, gsz = (nM - fm) < WGM ? (nM - fm) : WGM;
        u.pm = fm + ((wgid % nig) % gsz); u.pn = (wgid % nig) / gsz; u.ko = 0; return true;
    }
    __device__ __forceinline__ void a_ready(const Unit&) const {}
    __device__ __forceinline__ void done(const Unit&) const {}
};
struct ChainOrder {
    StaticOrder base; int seg_bytes;
    __host__ __device__ bool next(int i, Unit& u) const { const bool ok = base.next(i >> 1, u); u.ko = (i & 1) * seg_bytes; return ok; }
    __device__ __forceinline__ void a_ready(const Unit&) const {}
    __device__ __forceinline__ void done(const Unit&) const {}
};

__device__ __forceinline__ unsigned cvt_pk_bf16(float lo, float hi) { unsigned r; asm volatile("v_cvt_pk_bf16_f32 %0, %1, %2" : "=v"(r) : "v"(lo), "v"(hi)); return r; }
typedef float f32x2 __attribute__((ext_vector_type(2)));
__device__ __forceinline__ float bf_lo(unsigned w) { return __uint_as_float(w << 16); }
__device__ __forceinline__ float bf_hi(unsigned w) { return __uint_as_float(w & 0xffff0000u); }
__device__ __forceinline__ float sigmoid_f(float z) { return __builtin_amdgcn_rcpf(1.0f + __builtin_amdgcn_exp2f(-1.4426950408889634f * z)); }
__device__ __forceinline__ float gelu_tanh_f(float x) {
    const float t = x * (1.0f + 0.044715f * x * x);
    return x * __builtin_amdgcn_rcpf(1.0f + __builtin_amdgcn_exp2f(-2.302208198f * t));
}
__device__ __forceinline__ u32x4 pack8(const f32x4 v0, const f32x4 v1) { u32x4 w; w.x = cvt_pk_bf16(v0[0], v0[1]); w.y = cvt_pk_bf16(v0[2], v0[3]); w.z = cvt_pk_bf16(v1[0], v1[1]); w.w = cvt_pk_bf16(v1[2], v1[3]); return w; }

struct EpiIn {
    static constexpr bool PERM = true, AFTER_DRAIN = false, CHAIN = false;
    bf16_t *QA, *KVA, *QB, *KB, *VB, *GATE; const float* bgate;
    __device__ __forceinline__ void operator()(const f32x4 (&acc)[2][2][4][2], const Unit& u, int wr, int wc, int fr, int fq, PG8_LAS unsigned char*) const {
        const int pn = u.pn; bf16_t* base; int ldc, colt; bool sig = false;
        if (pn < 2) { base = QA; ldc = 512; colt = pn * 256; }
        else if (pn == 2) { base = KVA; ldc = 256; colt = 0; }
        else if (pn < 5) { base = QB; ldc = 512; colt = (pn - 3) * 256; }
        else if (pn < 7) { base = KB; ldc = 512; colt = (pn - 5) * 256; }
        else if (pn < 9) { base = VB; ldc = 512; colt = (pn - 7) * 256; }
        else { base = GATE; ldc = 2048; colt = (pn - 9) * 256; sig = true; }
        const int row0 = u.pm * BM + wr * 64 + fr, col0 = colt + wc * 32 + 8 * fq;
        f32x4 bv[2][2];
#pragma unroll
        for (int bj = 0; bj < 2; ++bj)
#pragma unroll
            for (int n = 0; n < 2; ++n) bv[bj][n] = sig ? *(const f32x4*)(bgate + col0 + bj * HALF + 4 * n) : (f32x4){0.f, 0.f, 0.f, 0.f};
#pragma unroll
        for (int ai = 0; ai < 2; ++ai)
#pragma unroll
            for (int m = 0; m < 4; ++m) { bf16_t* rowp = base + (size_t)(row0 + ai * HALF + m * 16) * ldc + col0;
#pragma unroll
                for (int bj = 0; bj < 2; ++bj) { f32x4 v0 = acc[ai][bj][m][0] + bv[bj][0], v1 = acc[ai][bj][m][1] + bv[bj][1];
                    if (sig) {
#pragma unroll
                        for (int i = 0; i < 4; ++i) { v0[i] = sigmoid_f(v0[i]); v1[i] = sigmoid_f(v1[i]); } }
                    *(u32x4*)(rowp + bj * HALF) = pack8(v0, v1); } }
    }
};

struct EpiMerge {
    static constexpr bool PERM = true, AFTER_DRAIN = false, CHAIN = true;
    const bf16_t* GATE; bf16_t* G;
    __device__ __forceinline__ void mid(f32x4 (&acc)[2][2][4][2], const Unit& u, int wr, int wc, int fr, int fq) const {
        const int row0 = u.pm * BM + wr * 64 + fr, col0 = u.pn * BM + wc * 32 + 8 * fq;
#pragma unroll
        for (int ai = 0; ai < 2; ++ai)
#pragma unroll
            for (int m = 0; m < 4; ++m) { const bf16_t* gp = GATE + (size_t)(row0 + ai * HALF + m * 16) * 2048 + col0;
#pragma unroll
                for (int bj = 0; bj < 2; ++bj) { const u32x4 ga = *(const u32x4*)(gp + bj * HALF), gb = *(const u32x4*)(gp + 1024 + bj * HALF);
#pragma unroll
                    for (int n = 0; n < 2; ++n) { const unsigned a0 = n ? ga.z : ga.x, a1 = n ? ga.w : ga.y, b0 = n ? gb.z : gb.x, b1 = n ? gb.w : gb.y;
                        f32x4 r; r[0] = bf_lo(a0) * __builtin_amdgcn_rcpf(bf_lo(b0)); r[1] = bf_hi(a0) * __builtin_amdgcn_rcpf(bf_hi(b0));
                        r[2] = bf_lo(a1) * __builtin_amdgcn_rcpf(bf_lo(b1)); r[3] = bf_hi(a1) * __builtin_amdgcn_rcpf(bf_hi(b1));
                        acc[ai][bj][m][n] = acc[ai][bj][m][n] * r; } }
                asm volatile("" ::: "memory"); }
    }
    __device__ __forceinline__ void operator()(f32x4 (&acc)[2][2][4][2], const Unit& u, int wr, int wc, int fr, int fq, PG8_LAS unsigned char*) const {
        if (u.ko == 0) { mid(acc, u, wr, wc, fr, fq); return; }
        const int row0 = u.pm * BM + wr * 64 + fr, col0 = u.pn * BM + wc * 32 + 8 * fq;
#pragma unroll
        for (int ai = 0; ai < 2; ++ai)
#pragma unroll
            for (int m = 0; m < 4; ++m) { const size_t r = (size_t)(row0 + ai * HALF + m * 16);
#pragma unroll
                for (int bj = 0; bj < 2; ++bj) { const u32x4 gb = *(const u32x4*)(GATE + r * 2048 + 1024 + col0 + bj * HALF);
                    f32x4 v0 = acc[ai][bj][m][0], v1 = acc[ai][bj][m][1];
                    v0[0] *= bf_lo(gb.x); v0[1] *= bf_hi(gb.x); v0[2] *= bf_lo(gb.y); v0[3] *= bf_hi(gb.y);
                    v1[0] *= bf_lo(gb.z); v1[1] *= bf_hi(gb.z); v1[2] *= bf_lo(gb.w); v1[3] *= bf_hi(gb.w);
                    *(u32x4*)(G + r * 1024 + col0 + bj * HALF) = pack8(v0, v1); } }
    }
};

struct EpiSS {
    static constexpr bool PERM = true, AFTER_DRAIN = false, CHAIN = false;
    bf16_t* O; float* SS;
    __device__ __forceinline__ void operator()(const f32x4 (&acc)[2][2][4][2], const Unit& u, int wr, int wc, int fr, int fq, PG8_LAS unsigned char*) const {
        const int row0 = u.pm * BM + wr * 64 + fr, col0 = u.pn * BM + wc * 32 + 8 * fq;
#pragma unroll
        for (int ai = 0; ai < 2; ++ai)
#pragma unroll
            for (int m = 0; m < 4; ++m) { const size_t r = (size_t)(row0 + ai * HALF + m * 16); float s = 0.f;
#pragma unroll
                for (int bj = 0; bj < 2; ++bj) { const f32x4 v0 = acc[ai][bj][m][0], v1 = acc[ai][bj][m][1];
                    s += (v0[0] * v0[0] + v0[1] * v0[1]) + (v0[2] * v0[2] + v0[3] * v0[3]) + (v1[0] * v1[0] + v1[1] * v1[1]) + (v1[2] * v1[2] + v1[3] * v1[3]);
                    *(u32x4*)(O + r * 1024 + col0 + bj * HALF) = pack8(v0, v1); }
                s += __shfl_xor(s, 16); s += __shfl_xor(s, 32);
                if (fq == 0) SS[r * 16 + u.pn * 4 + wc] = s; }
    }
};

constexpr int EDGE_OFF = 131072;
__device__ __forceinline__ float dpp_shr1(float old, float src) { return __int_as_float(__builtin_amdgcn_update_dpp(__float_as_int(old), __float_as_int(src), 0x111, 0xF, 0xF, false)); }
__device__ __forceinline__ float dpp_shl1(float old, float src) { return __int_as_float(__builtin_amdgcn_update_dpp(__float_as_int(old), __float_as_int(src), 0x101, 0xF, 0xF, false)); }
__device__ __forceinline__ float dpp_ror1(float src) { return __int_as_float(__builtin_amdgcn_update_dpp(0, __float_as_int(src), 0x121, 0xF, 0xF, false)); }
__device__ __forceinline__ float dpp_ror15(float src) { return __int_as_float(__builtin_amdgcn_update_dpp(0, __float_as_int(src), 0x12F, 0xF, 0xF, false)); }
struct EpiConv {
    static constexpr bool PERM = true, AFTER_DRAIN = false, CHAIN = false;
    bf16_t* ACT; float* HALO; const float* cw; const float* cb;
    __device__ __forceinline__ void operator()(const f32x4 (&acc)[2][2][4][2], const Unit& u, int wr, int wc, int fr, int fq, PG8_LAS unsigned char* lds) const {
        PG8_LAS float* edge = (PG8_LAS float*)(lds + EDGE_OFF);
        const int lc0 = wc * 32 + 8 * fq;
#pragma unroll
        for (int ai = 0; ai < 2; ++ai)
#pragma unroll
            for (int bj = 0; bj < 2; ++bj)
#pragma unroll
                for (int n = 0; n < 2; ++n) { const int lc = bj * HALF + lc0 + 4 * n;
                    if (fr == 0) *(PG8_LAS f32x4*)(edge + ((ai * 2 + wr) * 2 + 0) * 256 + lc) = acc[ai][bj][0][n];
                    if (fr == 15) *(PG8_LAS f32x4*)(edge + ((ai * 2 + wr) * 2 + 1) * 256 + lc) = acc[ai][bj][3][n]; }
        { float* hp = HALO + (size_t)u.pm * 4 * 5632 + u.pn * 256;
          if (wr == 0 && fr < 2) {
#pragma unroll
            for (int bj = 0; bj < 2; ++bj)
#pragma unroll
                for (int n = 0; n < 2; ++n) *(f32x4*)(hp + (size_t)fr * 5632 + bj * HALF + lc0 + 4 * n) = acc[0][bj][0][n]; }
          if (wr == 1 && fr >= 14) {
#pragma unroll
            for (int bj = 0; bj < 2; ++bj)
#pragma unroll
                for (int n = 0; n < 2; ++n) *(f32x4*)(hp + (size_t)(fr - 12) * 5632 + bj * HALF + lc0 + 4 * n) = acc[1][bj][3][n]; } }
        asm volatile("s_waitcnt lgkmcnt(0)" ::: "memory"); __builtin_amdgcn_s_barrier(); asm volatile("" ::: "memory");
        const int row0 = u.pm * BM + wr * 64 + fr;
#pragma unroll
        for (int n = 0; n < 2; ++n) {
            const int oc = u.pn * HALF + lc0 + 4 * n;
            f32x4 W[2][3], Bc[2];
#pragma unroll
            for (int bj = 0; bj < 2; ++bj) { Bc[bj] = *(const f32x4*)(cb + bj * 2816 + oc);
#pragma unroll
                for (int j = 0; j < 3; ++j) W[bj][j] = *(const f32x4*)(cw + (size_t)j * 5632 + bj * 2816 + oc); }
#pragma unroll
            for (int ai = 0; ai < 2; ++ai) {
                const int blk = ai * 2 + wr;
                f32x4 eup[2], edn[2];
#pragma unroll
                for (int bj = 0; bj < 2; ++bj) { const int lc = bj * HALF + lc0 + 4 * n;
                    eup[bj] = blk > 0 ? *(const PG8_LAS f32x4*)(edge + ((blk - 1) * 2 + 1) * 256 + lc) : (f32x4){0.f, 0.f, 0.f, 0.f};
                    edn[bj] = blk < 3 ? *(const PG8_LAS f32x4*)(edge + ((blk + 1) * 2 + 0) * 256 + lc) : (f32x4){0.f, 0.f, 0.f, 0.f}; }
#pragma unroll
                for (int m = 0; m < 4; ++m) { f32x4 cv[2];
#pragma unroll
                    for (int bj = 0; bj < 2; ++bj) { const f32x4 cur = acc[ai][bj][m][n];
#pragma unroll
                        for (int i = 0; i < 4; ++i) {
                            const float ue = (m > 0) ? dpp_ror1(acc[ai][bj][m > 0 ? m - 1 : 0][n][i]) : eup[bj][i];
                            const float de = (m < 3) ? dpp_ror15(acc[ai][bj][m < 3 ? m + 1 : 3][n][i]) : edn[bj][i];
                            const float up = dpp_shr1(ue, cur[i]), dn = dpp_shl1(de, cur[i]);
                            cv[bj][i] = W[bj][0][i] * up + W[bj][1][i] * cur[i] + W[bj][2][i] * dn + Bc[bj][i]; } }
                    typedef unsigned u32x2v __attribute__((ext_vector_type(2))); u32x2v w;
                    w.x = cvt_pk_bf16(gelu_tanh_f(cv[0][0]) * cv[1][0], gelu_tanh_f(cv[0][1]) * cv[1][1]);
                    w.y = cvt_pk_bf16(gelu_tanh_f(cv[0][2]) * cv[1][2], gelu_tanh_f(cv[0][3]) * cv[1][3]);
                    *(u32x2v*)(ACT + (size_t)(row0 + ai * HALF + m * 16) * 2816 + oc) = w; } } }
    }
};
template <class Epi, class Sched, bool ALIGN_EPI = true, bool SP2 = true>
__device__ __forceinline__ void gemm_phase(PG8_LAS unsigned char* lds, const Gemm g, const Sched& S, const Epi& E) {
    const int tid = threadIdx.x, wid = __builtin_amdgcn_readfirstlane(tid >> 6), lane = tid & 63, wr = wid >> 2, wc = wid & 3, fr = lane & 15, fq = lane >> 4;
    const int K = g.K, nt = K / BK;
    unsigned voffA[2], voffB[2];
#pragma unroll
    for (int i = 0; i < 2; ++i) { int R, C; stage_rc(tid * 16 + i * 8192, R, C); const int Rb = Epi::PERM ? ((R & ~31) + perm32(R & 31)) : R;
        voffA[i] = (unsigned)(R * g.lda + C) * 2u; voffB[i] = (unsigned)(Rb * g.ldb + C) * 2u; }
    const size_t kstep = (size_t)(BK * 2);
    const size_t hstepA = (size_t)HALF * g.lda * 2, hstepB = (size_t)HALF * g.ldb * 2;
    const size_t tstepA = 2 * hstepA, tstepB = 2 * hstepB;
    const unsigned ldsw = (unsigned)wid * 1024u;
    const int aoff = lds_byte(wr * 64 + fr, fq * 8), boff = lds_byte(wc * 32 + fr, fq * 8);
#define PG8_SA(b, h) (((b) * 2 + (h)) * HTB)
#define PG8_SB(b, h) ((4 + (b) * 2 + (h)) * HTB)
#define PG8_STAGE(bufoff, gbase, voff) do { _Pragma("unroll") for (int _i = 0; _i < 2; ++_i) \
        __builtin_amdgcn_global_load_lds((const unsigned*)((const char*)(gbase) + (voff)[_i]), (PG8_LAS unsigned*)(lds + (bufoff) + ldsw + _i * 8192), 16, 0, 0); } while (0)
#define PG8_LDA(dst, b, h) do { _Pragma("unroll") for (int m = 0; m < 4; ++m) _Pragma("unroll") for (int k = 0; k < 2; ++k) dst[m][k] = *(const PG8_LAS bf16x8*)(lds + PG8_SA(b, h) + aoff + m * 2048 + k * 1024); } while (0)
#define PG8_LDB(dst, b, h) do { _Pragma("unroll") for (int n = 0; n < 2; ++n) _Pragma("unroll") for (int k = 0; k < 2; ++k) dst[n][k] = *(const PG8_LAS bf16x8*)(lds + PG8_SB(b, h) + boff + n * 2048 + k * 1024); } while (0)
#define PG8_MMA(ai, bj, At, Bt) do { __builtin_amdgcn_s_setprio(1); _Pragma("unroll") for (int m = 0; m < 4; ++m) _Pragma("unroll") for (int n = 0; n < 2; ++n) _Pragma("unroll") for (int k = 0; k < 2; ++k) \
        acc[ai][bj][m][n] = __builtin_amdgcn_mfma_f32_16x16x32_bf16(Bt[n][k], At[m][k], acc[ai][bj][m][n], 0, 0, 0); __builtin_amdgcn_s_setprio(0); } while (0)
#define PG8_WAIT_V(n) asm volatile("s_waitcnt vmcnt(" #n ")" ::: "memory")
#define PG8_WAIT_L(n) asm volatile("s_waitcnt lgkmcnt(" #n ")" ::: "memory")
#define PG8_BAR __builtin_amdgcn_s_barrier()
#define PG8_SCHED __builtin_amdgcn_sched_barrier(0)
    Unit cur, nxt; int ui = 0;
    if (!S.next(0, cur)) return;
    f32x4 acc[2][2][4][2];
#pragma unroll
    for (int a = 0; a < 2; ++a)
#pragma unroll
        for (int b = 0; b < 2; ++b)
#pragma unroll
            for (int m = 0; m < 4; ++m)
#pragma unroll
                for (int n = 0; n < 2; ++n) acc[a][b][m][n] = (f32x4){0.f, 0.f, 0.f, 0.f};
    bf16x8 At[4][2], B0[2][2], B1[2][2];
    const char* cA = (const char*)g.A + (size_t)cur.pm * tstepA + cur.ko; const char* cB = (const char*)g.Bt + (size_t)cur.pn * tstepB + cur.ko;
    S.a_ready(cur);
    if constexpr (SP2) {
        PG8_STAGE(PG8_SB(0, 0), cB, voffB); PG8_STAGE(PG8_SB(0, 1), cB + hstepB, voffB); PG8_STAGE(PG8_SA(0, 0), cA, voffA); PG8_STAGE(PG8_SA(0, 1), cA + hstepA, voffA);
        if (wr == 1) PG8_BAR;
        PG8_WAIT_V(2); PG8_BAR;
        PG8_STAGE(PG8_SB(1, 0), cB + kstep, voffB); PG8_STAGE(PG8_SA(1, 0), cA + kstep, voffA); PG8_STAGE(PG8_SB(1, 1), cB + hstepB + kstep, voffB);
        PG8_WAIT_V(6); PG8_BAR;
    } else {
        PG8_STAGE(PG8_SB(0, 0), cB, voffB); PG8_STAGE(PG8_SA(0, 0), cA, voffA); PG8_STAGE(PG8_SB(0, 1), cB + hstepB, voffB); PG8_STAGE(PG8_SA(0, 1), cA + hstepA, voffA);
        if (wr == 1) PG8_BAR;
        PG8_WAIT_V(4); PG8_BAR;
        PG8_STAGE(PG8_SB(1, 0), cB + kstep, voffB); PG8_STAGE(PG8_SA(1, 0), cA + kstep, voffA); PG8_STAGE(PG8_SB(1, 1), cB + hstepB + kstep, voffB);
        PG8_WAIT_V(6); PG8_BAR;
    }
    for (;;) {
        const bool has_next = S.next(ui + 1, nxt);
        const char* nA = has_next ? (const char*)g.A + (size_t)nxt.pm * tstepA + nxt.ko : cA; const char* nB = has_next ? (const char*)g.Bt + (size_t)nxt.pn * tstepB + nxt.ko : cB;
        for (int t = 0; t < nt; t += 2) {
            const bool last = (t == nt - 2);
            const char* a1 = cA + (size_t)(t + 1) * kstep;
            const char* a2 = last ? nA : cA + (size_t)(t + 2) * kstep; const char* b2 = last ? nB : cB + (size_t)(t + 2) * kstep;
            const char* a3 = a2 + kstep; const char* b3 = b2 + kstep;
            if (last && has_next) S.a_ready(nxt);
            if constexpr (SP2) {
            PG8_LDB(B0, 0, 0); PG8_LDB(B1, 0, 1); PG8_SCHED; PG8_LDA(At, 0, 0); PG8_STAGE(PG8_SA(1, 1), a1 + hstepA, voffA);
            PG8_WAIT_V(8); PG8_WAIT_L(0); PG8_BAR; PG8_MMA(0, 0, At, B0); PG8_MMA(0, 1, At, B1); PG8_BAR; PG8_SCHED;
            PG8_LDA(At, 0, 1); PG8_STAGE(PG8_SB(0, 0), b2, voffB); PG8_STAGE(PG8_SB(0, 1), b2 + hstepB, voffB); PG8_STAGE(PG8_SA(0, 0), a2, voffA);
            PG8_WAIT_V(8); PG8_WAIT_L(0); PG8_BAR; PG8_MMA(1, 0, At, B0); PG8_MMA(1, 1, At, B1); PG8_BAR; PG8_SCHED;
            PG8_LDB(B0, 1, 0); PG8_LDB(B1, 1, 1); PG8_SCHED; PG8_LDA(At, 1, 0); PG8_STAGE(PG8_SA(0, 1), a2 + hstepA, voffA);
            PG8_WAIT_V(8); PG8_WAIT_L(0); PG8_BAR; PG8_MMA(0, 0, At, B0); PG8_MMA(0, 1, At, B1); PG8_BAR; PG8_SCHED;
            PG8_LDA(At, 1, 1); PG8_STAGE(PG8_SB(1, 0), b3, voffB); PG8_STAGE(PG8_SB(1, 1), b3 + hstepB, voffB); PG8_STAGE(PG8_SA(1, 0), a3, voffA);
            PG8_WAIT_V(8); PG8_WAIT_L(0); PG8_BAR; PG8_MMA(1, 0, At, B0); PG8_MMA(1, 1, At, B1); PG8_BAR; PG8_SCHED;
            } else {
            PG8_LDB(B0, 0, 0); PG8_SCHED; PG8_LDA(At, 0, 0); PG8_STAGE(PG8_SA(1, 1), a1 + hstepA, voffA);
            PG8_WAIT_L(8); PG8_BAR; PG8_WAIT_L(0); PG8_MMA(0, 0, At, B0); PG8_BAR; PG8_SCHED;
            PG8_LDB(B1, 0, 1); PG8_STAGE(PG8_SB(0, 0), b2, voffB);
            PG8_BAR; PG8_WAIT_L(0); PG8_MMA(0, 1, At, B1); PG8_BAR;
            PG8_LDA(At, 0, 1); PG8_STAGE(PG8_SA(0, 0), a2, voffA);
            PG8_BAR; PG8_WAIT_L(0); PG8_MMA(1, 0, At, B0); PG8_BAR; PG8_SCHED;
            PG8_STAGE(PG8_SB(0, 1), b2 + hstepB, voffB);
            PG8_WAIT_V(6); PG8_BAR; PG8_MMA(1, 1, At, B1); PG8_BAR;
            PG8_LDB(B0, 1, 0); PG8_SCHED; PG8_LDA(At, 1, 0); PG8_STAGE(PG8_SA(0, 1), a2 + hstepA, voffA);
            PG8_WAIT_L(8); PG8_BAR; PG8_WAIT_L(0); PG8_MMA(0, 0, At, B0); PG8_BAR; PG8_SCHED;
            PG8_LDB(B1, 1, 1); PG8_STAGE(PG8_SB(1, 0), b3, voffB);
            PG8_BAR; PG8_WAIT_L(0); PG8_MMA(0, 1, At, B1); PG8_BAR;
            PG8_LDA(At, 1, 1); PG8_STAGE(PG8_SA(1, 0), a3, voffA);
            PG8_BAR; PG8_WAIT_L(0); PG8_MMA(1, 0, At, B0); PG8_BAR; PG8_SCHED;
            PG8_STAGE(PG8_SB(1, 1), b3 + hstepB, voffB);
            PG8_WAIT_V(6); PG8_BAR; PG8_MMA(1, 1, At, B1); PG8_BAR;
            }
        }
        if constexpr (ALIGN_EPI) { if (wr == 0) PG8_BAR; }
        if constexpr (!Epi::AFTER_DRAIN) { E(acc, cur, wr, wc, fr, fq, lds); S.done(cur); }
        if (!has_next) break;
        if (!(Epi::CHAIN && cur.ko == 0))
#pragma unroll
        for (int a = 0; a < 2; ++a)
#pragma unroll
            for (int b = 0; b < 2; ++b)
#pragma unroll
                for (int m = 0; m < 4; ++m)
#pragma unroll
                    for (int n = 0; n < 2; ++n) acc[a][b][m][n] = (f32x4){0.f, 0.f, 0.f, 0.f};
        cur = nxt; cA = nA; cB = nB; ++ui;
        if constexpr (ALIGN_EPI) { if (wr == 1) PG8_BAR; }
    }
    PG8_WAIT_V(0);
    if constexpr (!ALIGN_EPI) { if (wr == 0) PG8_BAR; }
    PG8_BAR;
    if constexpr (Epi::AFTER_DRAIN) { E.fused(acc, cur, wr, wc, fr, fq, lds, wid, lane); S.done(cur); }
#undef PG8_SA
#undef PG8_SB
#undef PG8_STAGE
#undef PG8_LDA
#undef PG8_LDB
#undef PG8_MMA
#undef PG8_WAIT_V
#undef PG8_WAIT_L
#undef PG8_BAR
#undef PG8_SCHED
}
}
#include <hip/hip_bf16.h>
#include <cmath>
namespace attn_body {
using bf16=__hip_bfloat16;
using bf16x8=__attribute__((ext_vector_type(8)))short;
using s16x4=__attribute__((ext_vector_type(4)))short;
using f32x16=__attribute__((ext_vector_type(16)))float;
using u32x4=__attribute__((ext_vector_type(4)))unsigned;
constexpr int D=64,QP=512,KP=256,OP=1024;
constexpr int NW=8,QBLK=32,QB=QBLK*NW,KVBLK=64;
__device__ __forceinline__ int crow(int r,int hi){return (r&3)+8*(r>>2)+4*hi;}
#define SBAR() __builtin_amdgcn_sched_barrier(0)
__device__ __forceinline__ void cmask(f32x16&p0,f32x16&p1,int jb,int qrel,int hi){
  const float NEG=-INFINITY; int kb=64*jb+4*hi;
  #pragma unroll
  for(int r=0;r<16;++r){int kv=kb+(r&3)+8*(r>>2); if(kv>qrel)p0[r]=NEG; if(kv+32>qrel)p1[r]=NEG;}
}

constexpr int NSLOT=3, SLOTB=8192;
constexpr int LDS_K=0, LDS_V=NSLOT*SLOTB, LDS_WS=2*NSLOT*SLOTB, LDS_OST=LDS_WS+NW*64*4, LDS_BYTES=LDS_OST+NW*4096;
constexpr float C2=0.125f*1.4426950408889634f;
__device__ __forceinline__ void glds16(const void*gsrc,unsigned lds_dst){unsigned keep;
  asm volatile("s_mov_b32 %0, m0\n\ts_mov_b32 m0, %2\n\ts_nop 0\n\tglobal_load_lds_dwordx4 %1, off\n\ts_mov_b32 m0, %0":"=&s"(keep):"v"(gsrc),"s"(lds_dst):"memory");}
__device__ __forceinline__ float max3f(float a,float b,float c){float r;asm("v_max3_f32 %0, %1, %2, %3":"=v"(r):"v"(a),"v"(b),"v"(c));return r;}
__device__ __forceinline__ float max2f(float a,float b){float r;asm("v_max_f32_e32 %0, %1, %2":"=v"(r):"v"(a),"v"(b));return r;}
__device__ __forceinline__ float fadd_s(float a,float b){float r;asm("v_add_f32_e32 %0, %1, %2":"=v"(r):"v"(a),"v"(b));return r;}
__device__ __forceinline__ float fsub_s(float a,float b){float r;asm("v_sub_f32_e32 %0, %1, %2":"=v"(r):"v"(a),"v"(b));return r;}
typedef float f32x2_t __attribute__((ext_vector_type(2))); typedef __bf16 bf16x2_t __attribute__((ext_vector_type(2)));
__device__ __forceinline__ unsigned cvtpk_s(float lo,float hi){f32x2_t v={lo,hi};bf16x2_t b=__builtin_convertvector(v,bf16x2_t);return __builtin_bit_cast(unsigned,b);}
#define WAIT_BAR(N) asm volatile("s_waitcnt vmcnt(" #N ") lgkmcnt(0)\n\ts_barrier":::"memory")

__device__ __forceinline__ void qkt(f32x16&p0,f32x16&p1,const char*Kslot,const bf16x8*qr,const f32x16&negm,int r32,int hi){
  const char*kb=Kslot+hi*1024+r32*16;
  #pragma unroll
  for(int d0=0;d0<4;++d0){
    const bf16x8 b0=*reinterpret_cast<const bf16x8*>(kb+d0*2048);
    const bf16x8 b1=*reinterpret_cast<const bf16x8*>(kb+d0*2048+512);
    if(d0==0){p0=__builtin_amdgcn_mfma_f32_32x32x16_bf16(b0,qr[0],negm,0,0,0);p1=__builtin_amdgcn_mfma_f32_32x32x16_bf16(b1,qr[0],negm,0,0,0);}
    else{p0=__builtin_amdgcn_mfma_f32_32x32x16_bf16(b0,qr[d0],p0,0,0,0);p1=__builtin_amdgcn_mfma_f32_32x32x16_bf16(b1,qr[d0],p1,0,0,0);}}
}
typedef __attribute__((address_space(3))) const char* lds_cptr;
typedef short v4i16_t __attribute__((ext_vector_type(4)));
__device__ __forceinline__ void kload8(bf16x8*kf,lds_cptr kp){
  kf[0]=*(const __attribute__((address_space(3))) bf16x8*)(kp);      kf[1]=*(const __attribute__((address_space(3))) bf16x8*)(kp+512);
  kf[2]=*(const __attribute__((address_space(3))) bf16x8*)(kp+2048); kf[3]=*(const __attribute__((address_space(3))) bf16x8*)(kp+2560);
  kf[4]=*(const __attribute__((address_space(3))) bf16x8*)(kp+4096); kf[5]=*(const __attribute__((address_space(3))) bf16x8*)(kp+4608);
  kf[6]=*(const __attribute__((address_space(3))) bf16x8*)(kp+6144); kf[7]=*(const __attribute__((address_space(3))) bf16x8*)(kp+6656);
}
__device__ __forceinline__ void kload2(bf16x8*kf,lds_cptr kp,int j){ kf[2*j]=*(const __attribute__((address_space(3))) bf16x8*)(kp+j*2048); kf[2*j+1]=*(const __attribute__((address_space(3))) bf16x8*)(kp+j*2048+512); }
__device__ __forceinline__ s16x4 vtr(lds_cptr p){ return __builtin_bit_cast(s16x4,__builtin_amdgcn_ds_read_tr16_b64_v4i16((__attribute__((address_space(3))) v4i16_t*)p)); }
__device__ __forceinline__ float rowmax(const f32x16&p0,const f32x16&p1){
  float a=max3f(p0[0],p0[1],p1[0]),b=max3f(p0[2],p0[3],p1[1]);a=max3f(a,p1[2],p1[3]);
  #pragma unroll
  for(int r=4;r<16;r+=4){a=max3f(a,p0[r],p0[r+1]);b=max3f(b,p0[r+2],p0[r+3]);a=max3f(a,p1[r],p1[r+1]);b=max3f(b,p1[r+2],p1[r+3]);}
  const float m=max2f(a,b);
  auto rr=__builtin_amdgcn_permlane32_swap(__float_as_uint(m),__float_as_uint(m),false,false);
  return max2f(__uint_as_float(rr[0]),__uint_as_float(rr[1]));
}
__device__ __forceinline__ void pv(f32x16*o,int vb,bf16x8 pa0,bf16x8 pa1,bf16x8 pa2,bf16x8 pa3){
  #pragma unroll
  for(int d0=0;d0<2;++d0){s16x4 lo[4],hi[4];
    #pragma unroll
    for(int ks=0;ks<4;++ks){
      asm volatile("ds_read_b64_tr_b16 %0,%1 offset:%c2":"=&v"(lo[ks]):"v"(vb),"i"(d0*4096+ks*1024):"memory");
      asm volatile("ds_read_b64_tr_b16 %0,%1 offset:%c2":"=&v"(hi[ks]):"v"(vb),"i"(d0*4096+ks*1024+512):"memory");}
    asm volatile("s_waitcnt lgkmcnt(0)":::"memory");SBAR();
    #define PK(k) (bf16x8){lo[k][0],lo[k][1],lo[k][2],lo[k][3],hi[k][0],hi[k][1],hi[k][2],hi[k][3]}
    o[d0]=__builtin_amdgcn_mfma_f32_32x32x16_bf16(pa0,PK(0),o[d0],0,0,0);
    o[d0]=__builtin_amdgcn_mfma_f32_32x32x16_bf16(pa1,PK(1),o[d0],0,0,0);
    o[d0]=__builtin_amdgcn_mfma_f32_32x32x16_bf16(pa2,PK(2),o[d0],0,0,0);
    o[d0]=__builtin_amdgcn_mfma_f32_32x32x16_bf16(pa3,PK(3),o[d0],0,0,0);
    #undef PK
  }
}

#ifndef ATTN_STORE16
#define ATTN_STORE16(p,v) (*(u32x4*)(p)=(v))
#endif
template<int THRL> __device__ __forceinline__ void attn_unit(long rowbase,int NT,int h,int q0,const bf16*Q,const bf16*__restrict__ K,const bf16*__restrict__ V,bf16*O,char*shm){
  const int tid=threadIdx.x,lane=tid&63,r32=lane&31,hi=lane>>5; const int wid=__builtin_amdgcn_readfirstlane(tid>>6);
  const bf16*Qw=Q+(rowbase+q0+wid*QBLK)*QP+h*D;
  const bf16*Kh=K+rowbase*KP+(h>>2)*D,*Vh=V+rowbase*KP+(h>>2)*D;
  const unsigned lds0=(unsigned)(uintptr_t)shm;
  float*wsf=(float*)(shm+LDS_WS)+wid*64;
  const bf16*ksrc=Kh+(long)lane*KP+wid*8;
  const bf16*vsrc=Vh+(long)(16*(wid&3)+(lane>>2))*KP+(wid>>2)*32+(lane&3)*8;
  const unsigned kdst=lds0+LDS_K+wid*1024, vdst=lds0+LDS_V+wid*1024;
  #define DMA_K(t,slot) glds16(ksrc+(long)(t)*KVBLK*KP,(unsigned)__builtin_amdgcn_readfirstlane(kdst+(slot)))
  #define DMA_V(t,slot) glds16(vsrc+(long)(t)*KVBLK*KP,(unsigned)__builtin_amdgcn_readfirstlane(vdst+(slot)))
  const int vb0=(int)(lds0+LDS_V)+((lane>>4)&1)*32+(lane&3)*8+(4*hi+((lane&15)>>2))*64;
  const char*Kbase=shm+LDS_K; bf16x8 kf[8];
  const lds_cptr shm3=(lds_cptr)shm; const lds_cptr kp0=shm3+LDS_K+hi*1024+r32*16; const lds_cptr vp0=shm3+LDS_V+((lane>>4)&1)*32+(lane&3)*8+(4*hi+((lane&15)>>2))*64;
  DMA_K(0,0);DMA_V(0,0);DMA_K(1,SLOTB);
  bf16x8 qr[4];
  #pragma unroll
  for(int d0=0;d0<4;++d0)qr[d0]=*reinterpret_cast<const bf16x8*>(&Qw[(long)r32*QP+d0*16+hi*8]);
  float mhat=0.f,l_reg=0.f;f32x16 o[2];o[0]=f32x16{};o[1]=f32x16{};f32x16 negm=f32x16{};asm volatile("":"+v"(negm));
  #define CMASK(P0,P1,t) do{}while(0)
  bool resc=false;
  #define START(P0,P1) do{ const float rm=rowmax(P0,P1); resc=false; \
    { const float dl=rm; mhat=fadd_s(mhat,dl); \
      _Pragma("unroll") for(int r=0;r<16;++r){P0[r]=fsub_s(P0[r],dl);P1[r]=fsub_s(P1[r],dl);} \
      _Pragma("unroll") for(int r=0;r<16;++r)negm[r]=-mhat; asm volatile("":"+v"(negm)); } \
    _Pragma("unroll") for(int r=0;r<16;++r)P0[r]=__builtin_amdgcn_exp2f(P0[r]); }while(0)
  #define RESC() do{ if(resc){ asm volatile("s_waitcnt lgkmcnt(0)":::"memory"); \
      _Pragma("unroll") for(int d_=0;d_<2;++d_) _Pragma("unroll") for(int r=0;r<16;++r)o[d_][r]*=wsf[crow(r,hi)]; } }while(0)
  f32x16 pA0,pA1,pB0,pB1;
  int sl_prev=0,sl_cur=0,sl_next=SLOTB;
  #define ROT() do{sl_prev=sl_cur;sl_cur=sl_next;sl_next=(sl_next==(NSLOT-1)*SLOTB)?0:sl_next+SLOTB;}while(0)
  DMA_K(2,2*SLOTB);
  WAIT_BAR(3);
  qkt(pA0,pA1,Kbase,qr,negm,r32,hi);asm volatile("s_nop 15\n\ts_nop 7":"+v"(pA0),"+v"(pA1));CMASK(pA0,pA1,0);
  START(pA0,pA1);
  _Pragma("unroll") for(int r=0;r<16;++r)pA1[r]=__builtin_amdgcn_exp2f(pA1[r]);
  WAIT_BAR(0);
  DMA_K(3,0);DMA_V(1,SLOTB);
  ROT();
  kload8(kf,kp0+sl_cur);
  WAIT_BAR(2);
  s16x4 vlo[8],vhi[8]; u32x4 pw0,pw1,pw2,pw3;
  #define PKW(P,B) cvtpk_s(P[B],P[B+1])
  #define PAF(k) __builtin_bit_cast(bf16x8,pw##k)
  #define VFR(i) (bf16x8){vlo[i][0],vlo[i][1],vlo[i][2],vlo[i][3],vhi[i][0],vhi[i][1],vhi[i][2],vhi[i][3]}
  #define PIN(x) asm volatile("":"+v"(x))
  #define MX3(a,b,c) __builtin_fmaxf(__builtin_fmaxf((a),(b)),(c))
  #define GAPA(MF,A0,A1,A2,A3,W0,W1,PW) do{ MF; sacc+=A0; sacc+=A1; sacc+=A2; sacc+=A3; PIN(sacc); W0; W1; PIN(PW); SBAR(); }while(0)
  #define EX(v) __builtin_amdgcn_exp2f(v)
  #define GAPB(MF,X,B) do{ MF; X[B]=EX(X[B]); X[B+1]=EX(X[B+1]); X[B+2]=EX(X[B+2]); X[B+3]=EX(X[B+3]); PIN(X); SBAR(); }while(0)
  #define VRD(i) do{ vlo[i]=vtr(vp_+(((i)>>2)*4096+((i)&3)*1024)); vhi[i]=vtr(vp_+(((i)>>2)*4096+((i)&3)*1024+512)); }while(0)
  #define KRD(G,j) do{ if(G){ kload2(kf,kp0+sl_next,j); SBAR(); } }while(0)
  #define STEP(C0,C1,P0,P1,t,GK,GV,GL) do{ SBAR(); \
    const lds_cptr vp_=vp0+sl_prev; \
    VRD(0); SBAR(); float sacc=(P0[0]+P0[1]); \
    GAPA(C0=__builtin_amdgcn_mfma_f32_32x32x16_bf16(kf[0],qr[0],negm,0,0,0), P0[2],P0[3],P0[4],P0[5],     pw0[0]=PKW(P0,0), pw0[1]=PKW(P0,2), pw0); \
    VRD(4); SBAR(); GAPA(C1=__builtin_amdgcn_mfma_f32_32x32x16_bf16(kf[1],qr[0],negm,0,0,0), P0[6],P0[7],P0[8],P0[9],     pw0[2]=PKW(P0,4), pw0[3]=PKW(P0,6), pw0); \
    VRD(1); SBAR(); GAPA(C0=__builtin_amdgcn_mfma_f32_32x32x16_bf16(kf[2],qr[1],C0,0,0,0),   P0[10],P0[11],P0[12],P0[13], pw1[0]=PKW(P0,8), pw1[1]=PKW(P0,10), pw1); \
    VRD(5); SBAR(); GAPA(C1=__builtin_amdgcn_mfma_f32_32x32x16_bf16(kf[3],qr[1],C1,0,0,0),   P0[14],P0[15],P1[0],P1[1],   pw1[2]=PKW(P0,12),pw1[3]=PKW(P0,14), pw1); \
    VRD(2); SBAR(); GAPA(C0=__builtin_amdgcn_mfma_f32_32x32x16_bf16(kf[4],qr[2],C0,0,0,0),   P1[2],P1[3],P1[4],P1[5],     pw2[0]=PKW(P1,0), pw2[1]=PKW(P1,2), pw2); \
    VRD(6); SBAR(); GAPA(C1=__builtin_amdgcn_mfma_f32_32x32x16_bf16(kf[5],qr[2],C1,0,0,0),   P1[6],P1[7],P1[8],P1[9],     pw2[2]=PKW(P1,4), pw2[3]=PKW(P1,6), pw2); \
    VRD(3); SBAR(); GAPA(C0=__builtin_amdgcn_mfma_f32_32x32x16_bf16(kf[6],qr[3],C0,0,0,0),   P1[10],P1[11],P1[12],P1[13], pw3[0]=PKW(P1,8), pw3[1]=PKW(P1,10), pw3); \
    VRD(7); SBAR(); GAPA(C1=__builtin_amdgcn_mfma_f32_32x32x16_bf16(kf[7],qr[3],C1,0,0,0),   P1[14],P1[15],0.f,0.f,       pw3[2]=PKW(P1,12),pw3[3]=PKW(P1,14), pw3); \
    l_reg+=sacc; \
    if(GK){DMA_K((t)+3,sl_cur);} if(GV){DMA_V((t)+1,sl_next);} \
    CMASK(C0,C1,t); \
    { float a=MX3(C0[0],C0[1],C1[0]),b=MX3(C0[2],C0[3],C1[1]); a=MX3(a,C1[2],C1[3]); \
      _Pragma("unroll") for(int r=4;r<16;r+=4){a=MX3(a,C0[r],C0[r+1]);b=MX3(b,C0[r+2],C0[r+3]);a=MX3(a,C1[r],C1[r+1]);b=MX3(b,C1[r+2],C1[r+3]);} \
      float rm=__builtin_fmaxf(a,b); { auto rr=__builtin_amdgcn_permlane32_swap(__float_as_uint(rm),__float_as_uint(rm),false,false); rm=__builtin_fmaxf(__uint_as_float(rr[0]),__uint_as_float(rr[1])); } \
      resc=false; \
      if(__builtin_expect(__any(rm>(float)THRL),0)){ const float dl=__builtin_fmaxf(rm,0.f); mhat+=dl; \
        _Pragma("unroll") for(int r=0;r<16;++r){C0[r]-=dl;C1[r]-=dl;} \
        _Pragma("unroll") for(int r=0;r<16;++r)negm[r]=-mhat; asm volatile("":"+v"(negm)); \
        const float f=__builtin_amdgcn_exp2f(-dl); l_reg*=f; if(hi==0)wsf[r32]=f; resc=true; } } \
    SBAR(); \
    GAPB(o[0]=__builtin_amdgcn_mfma_f32_32x32x16_bf16(PAF(0),VFR(0),o[0],0,0,0), C0,0); \
    GAPB(o[1]=__builtin_amdgcn_mfma_f32_32x32x16_bf16(PAF(0),VFR(4),o[1],0,0,0), C0,4); \
    KRD(GL,0); GAPB(o[0]=__builtin_amdgcn_mfma_f32_32x32x16_bf16(PAF(1),VFR(1),o[0],0,0,0), C0,8); \
    KRD(GL,1); GAPB(o[1]=__builtin_amdgcn_mfma_f32_32x32x16_bf16(PAF(1),VFR(5),o[1],0,0,0), C0,12); \
    KRD(GL,2); GAPB(o[0]=__builtin_amdgcn_mfma_f32_32x32x16_bf16(PAF(2),VFR(2),o[0],0,0,0), C1,0); \
    KRD(GL,3); GAPB(o[1]=__builtin_amdgcn_mfma_f32_32x32x16_bf16(PAF(2),VFR(6),o[1],0,0,0), C1,4); \
    GAPB(o[0]=__builtin_amdgcn_mfma_f32_32x32x16_bf16(PAF(3),VFR(3),o[0],0,0,0), C1,8); \
    GAPB(o[1]=__builtin_amdgcn_mfma_f32_32x32x16_bf16(PAF(3),VFR(7),o[1],0,0,0), C1,12); \
    }while(0)
  int t=1;
  #undef CMASK
  #define CMASK(P0,P1,t) do{}while(0)
  for(;t+5<NT;t+=2){
    STEP(pB0,pB1,pA0,pA1,t,true,true,true);     WAIT_BAR(2); RESC(); ROT();
    STEP(pA0,pA1,pB0,pB1,t+1,true,true,true);   WAIT_BAR(2); RESC(); ROT();
  }
  #undef CMASK
  #define CMASK(P0,P1,t) do{}while(0)
  #define ENDW(tt) do{ if((tt)+3<NT){WAIT_BAR(2);} else if((tt)+2<NT){WAIT_BAR(1);} else {WAIT_BAR(0);} }while(0)
  for(;t+1<NT;t+=2){
    STEP(pB0,pB1,pA0,pA1,t,(t+3<NT),(t+1<NT),(t+1<NT));       ENDW(t);   RESC(); ROT();
    STEP(pA0,pA1,pB0,pB1,t+1,(t+4<NT),(t+2<NT),(t+2<NT));     ENDW(t+1); RESC(); ROT();
  }
  STEP(pB0,pB1,pA0,pA1,NT-1,false,false,false); RESC();
  { float sacc=pB0[0]+pB0[1]; _Pragma("unroll") for(int r=2;r<16;++r)sacc+=pB0[r]; _Pragma("unroll") for(int r=0;r<16;++r)sacc+=pB1[r]; l_reg+=sacc;
    pw0=(u32x4){PKW(pB0,0),PKW(pB0,2),PKW(pB0,4),PKW(pB0,6)};pw1=(u32x4){PKW(pB0,8),PKW(pB0,10),PKW(pB0,12),PKW(pB0,14)};pw2=(u32x4){PKW(pB1,0),PKW(pB1,2),PKW(pB1,4),PKW(pB1,6)};pw3=(u32x4){PKW(pB1,8),PKW(pB1,10),PKW(pB1,12),PKW(pB1,14)};
    SBAR(); pv(o,vb0+sl_cur,PAF(0),PAF(1),PAF(2),PAF(3)); }
  #undef PKW
  #undef PAF
  #undef VFR
  #undef PIN
  #undef MX3
  #undef GAPA
  #undef GAPB
  #undef EX
  #undef VRD
  #undef KRD
  #undef STEP
  #undef ENDW
  {auto rr=__builtin_amdgcn_permlane32_swap(__float_as_uint(l_reg),__float_as_uint(l_reg),false,false);l_reg=__uint_as_float(rr[0])+__uint_as_float(rr[1]);}
  if(hi==0)wsf[32+r32]=l_reg;asm volatile("s_waitcnt lgkmcnt(0)":::"memory");
  float rli[16];
  #pragma unroll
  for(int r=0;r<16;++r)rli[r]=__builtin_amdgcn_rcpf(wsf[32+crow(r,hi)]);
  bf16*Ow=O+(rowbase+q0+wid*QBLK)*OP+h*D;
  { bf16*stg=(bf16*)(shm+LDS_OST)+wid*2048;
    #pragma unroll
    for(int r=0;r<16;++r){const int orow=crow(r,hi);
      #pragma unroll
      for(int d0=0;d0<2;++d0)stg[orow*64+d0*32+r32]=__float2bfloat16(o[d0][r]*rli[r]);}
    asm volatile("s_waitcnt lgkmcnt(0)":::"memory");
    #pragma unroll
    for(int i=0;i<4;++i){const int row=i*8+(lane>>3),ch=lane&7; const u32x4 v=*(const u32x4*)(stg+row*64+ch*8); ATTN_STORE16(Ow+(long)row*OP+ch*8,v);} }
  asm volatile("s_waitcnt lgkmcnt(0)\n\ts_barrier":::"memory");
  #undef DMA_K
  #undef DMA_V
  #undef CMASK
  #undef START
  #undef RESC
  #undef ROT
}
constexpr int ATTN_LDS_BYTES=LDS_BYTES;
#undef SBAR
#undef WAIT_BAR
}
namespace nat {
#define NLAS __attribute__((address_space(3)))
typedef short bf16x8 __attribute__((ext_vector_type(8)));
typedef short s16x4 __attribute__((ext_vector_type(4)));
typedef float f32x4 __attribute__((ext_vector_type(4)));
typedef unsigned u32x4 __attribute__((ext_vector_type(4)));
typedef unsigned u32x2 __attribute__((ext_vector_type(2)));
typedef unsigned short bf16_t;
constexpr int VP = 144, VSLOT = 32 * VP;
constexpr int RPB_OFF = 8 * 2 * VSLOT;
__device__ __forceinline__ s16x4 vtr(const NLAS unsigned char* p) { return __builtin_bit_cast(s16x4, __builtin_amdgcn_ds_read_tr16_b64_v4i16((NLAS s16x4*)p)); }
__device__ __forceinline__ unsigned cvtpk(float lo, float hi) { unsigned r; asm volatile("v_cvt_pk_bf16_f32 %0, %1, %2" : "=v"(r) : "v"(lo), "v"(hi)); return r; }
__device__ __forceinline__ void item(const bf16_t* __restrict__ QB, const bf16_t* __restrict__ KB, const bf16_t* __restrict__ VB, bf16_t* __restrict__ OAB,
                                     const NLAS float* rpb, NLAS unsigned char* vbuf, int it, int lane) {
    const int j = it & 3, h = (it >> 2) & 7, rb = it >> 5;
    long row0; int r, nrows;
    if (rb < 1024) { row0 = (long)(rb >> 5) * 2048; r = rb & 31; nrows = 32; } else { const int t = rb - 1024; row0 = 65536 + (long)(t >> 7) * 8192; r = t & 127; nrows = 128; }
    const int q = lane & 15, g = lane >> 4, qc = 16 * j + q;
    const int kc0 = (j == 0) ? 0 : (j == 1) ? 8 : (j == 2) ? 24 : 32;
    int rs = r - 4; rs = rs < 0 ? 0 : (rs > nrows - 8 ? nrows - 8 : rs);
    const bf16_t* qp = QB + (size_t)(row0 + r * 64 + qc) * 512 + h * 64 + 8 * g;
    const bf16x8 bq0 = *(const bf16x8*)qp, bq1 = *(const bf16x8*)(qp + 32);
    const bf16_t* kbase = KB + (size_t)(row0 + rs * 64 + kc0 + q) * 512 + h * 64 + 8 * g;
    f32x4 s[8][2];
#pragma unroll
    for (int w = 0; w < 8; ++w)
#pragma unroll
        for (int kt = 0; kt < 2; ++kt) { const bf16_t* kp = kbase + (size_t)(w * 64 + kt * 16) * 512;
            const bf16x8 a0 = *(const bf16x8*)kp, a1 = *(const bf16x8*)(kp + 32);
            f32x4 c = (f32x4){0.f, 0.f, 0.f, 0.f};
            c = __builtin_amdgcn_mfma_f32_16x16x32_bf16(a0, bq0, c, 0, 0, 0); c = __builtin_amdgcn_mfma_f32_16x16x32_bf16(a1, bq1, c, 0, 0, 0);
            s[w][kt] = c; }
    int cs = qc - 8; cs = cs < 0 ? 0 : (cs > 48 ? 48 : cs);
    const NLAS float* rp = rpb + h * 465 + (rs - r + 7) * 31;
    float mx = -INFINITY;
#pragma unroll
    for (int w = 0; w < 8; ++w)
#pragma unroll
        for (int kt = 0; kt < 2; ++kt)
#pragma unroll
            for (int i = 0; i < 4; ++i) { const int kc = kc0 + 16 * kt + 4 * g + i; int ci = kc - qc + 15; ci = ci < 0 ? 0 : (ci > 30 ? 30 : ci);
                const float v = (kc >= cs && kc < cs + 16) ? s[w][kt][i] * 0.125f + rp[w * 31 + ci] : -INFINITY;
                s[w][kt][i] = v; mx = fmaxf(mx, v); }
    mx = fmaxf(mx, __shfl_xor(mx, 16)); mx = fmaxf(mx, __shfl_xor(mx, 32));
    float sum = 0.f;
#pragma unroll
    for (int w = 0; w < 8; ++w)
#pragma unroll
        for (int kt = 0; kt < 2; ++kt)
#pragma unroll
            for (int i = 0; i < 4; ++i) { const float p = __builtin_amdgcn_exp2f((s[w][kt][i] - mx) * 1.4426950408889634f); s[w][kt][i] = p; sum += p; }
    sum += __shfl_xor(sum, 16); sum += __shfl_xor(sum, 32);
    const float inv = 1.0f / sum;
    f32x4 o[4];
#pragma unroll
    for (int dt = 0; dt < 4; ++dt) o[dt] = (f32x4){0.f, 0.f, 0.f, 0.f};
    const bf16_t* vbase = VB + (size_t)(row0 + rs * 64 + kc0 + (lane >> 1)) * 512 + h * 64 + (lane & 1) * 32;
    const int qq = (lane & 15) >> 2, pp = lane & 3;
#pragma unroll
    for (int w = 0; w < 8; ++w) {
        const bf16_t* vp = vbase + (size_t)w * 64 * 512;
        NLAS unsigned char* vb = vbuf + (w & 1) * VSLOT;
        const u32x4 v0 = *(const u32x4*)vp, v1 = *(const u32x4*)(vp + 8), v2 = *(const u32x4*)(vp + 16), v3 = *(const u32x4*)(vp + 24);
        NLAS unsigned char* wp = vb + (lane >> 1) * VP + (lane & 1) * 64;
        *(NLAS u32x4*)wp = v0; *(NLAS u32x4*)(wp + 16) = v1; *(NLAS u32x4*)(wp + 32) = v2; *(NLAS u32x4*)(wp + 48) = v3;
        u32x4 pw; pw.x = cvtpk(s[w][0][0], s[w][0][1]); pw.y = cvtpk(s[w][0][2], s[w][0][3]); pw.z = cvtpk(s[w][1][0], s[w][1][1]); pw.w = cvtpk(s[w][1][2], s[w][1][3]);
        const bf16x8 pb = __builtin_bit_cast(bf16x8, pw);
#pragma unroll
        for (int dt = 0; dt < 4; ++dt) {
            const s16x4 lo = vtr(vb + (4 * g + qq) * VP + dt * 32 + 8 * pp), hi = vtr(vb + (16 + 4 * g + qq) * VP + dt * 32 + 8 * pp);
            const bf16x8 a = (bf16x8){lo[0], lo[1], lo[2], lo[3], hi[0], hi[1], hi[2], hi[3]};
            o[dt] = __builtin_amdgcn_mfma_f32_16x16x32_bf16(a, pb, o[dt], 0, 0, 0); }
    }
    bf16_t* op = OAB + (size_t)(row0 + r * 64 + qc) * 1024 + 512 + h * 64 + 4 * g;
#pragma unroll
    for (int dt = 0; dt < 4; ++dt) { u32x2 w2; w2.x = cvtpk(o[dt][0] * inv, o[dt][1] * inv); w2.y = cvtpk(o[dt][2] * inv, o[dt][3] * inv); *(u32x2*)(op + 16 * dt) = w2; }
}
#undef NLAS
}
constexpr int NWAVES = 8;
constexpr int M = 81920, MP = 65536, DMODEL = 1024, DIN = 4352, DFF = 2816, DUP = 5632;
constexpr float EPS = 1e-6f;
constexpr size_t MiB = 1u << 20;
constexpr size_t WS_TAB = 1 * MiB, WS_WIN = 2 * MiB, WS_WCAT = 11 * MiB, WS_WOUT = 13 * MiB, WS_WUP = 15 * MiB, WS_WDN = 26 * MiB;
constexpr size_t WS_SS1 = 32 * MiB, WS_SS2 = 37 * MiB, WS_HALO = 42 * MiB;
constexpr size_t WS_XN = 72 * MiB;
constexpr size_t WS_QA = 232 * MiB, WS_KVA = 312 * MiB, WS_QB = 352 * MiB, WS_KB = 432 * MiB, WS_VB = 512 * MiB, WS_GATE = 592 * MiB;
constexpr size_t WS_G = 432 * MiB;
constexpr size_t WS_MIX = 232 * MiB;
constexpr size_t WS_ACT = 432 * MiB;
constexpr size_t WS_END = 912 * MiB;
static_assert(WS_HALO + (size_t)320 * 4 * 5632 * 4 <= WS_XN && WS_ACT + (size_t)M * DFF * 2 <= WS_END && WS_GATE + (size_t)M * 2048 * 2 <= WS_END, "d_ws map");
constexpr int RING_BYTES = 131072, LDS_BYTES = 147456;

#define GAS __attribute__((address_space(1)))
#define LAS __attribute__((address_space(3)))
typedef unsigned short bf16;
typedef unsigned v4u __attribute__((ext_vector_type(4)));
typedef unsigned v2u __attribute__((ext_vector_type(2)));
typedef float f32x4 __attribute__((ext_vector_type(4)));
#define LDS_WAIT() asm volatile("s_waitcnt lgkmcnt(0)" ::: "memory")
__device__ __forceinline__ unsigned pk2(float lo, float hi) { return pg8::cvt_pk_bf16(lo, hi); }
__device__ __forceinline__ float wave_sum(float v) {
#pragma unroll
    for (int o = 1; o < 64; o <<= 1) v += __shfl_xor(v, o);
    return v;
}
__device__ __forceinline__ void p0_transpose_item(const float* W, int N, bf16* WT, int ldk, int koff, int drow0, LAS float* scr, int k0, int n0, int lane) {
#pragma unroll 8
    for (int i = 0; i < 32; ++i) { const int kk = 2 * i + (lane >> 5); scr[kk * 33 + (lane & 31)] = W[(size_t)(k0 + kk) * N + n0 + (lane & 31)]; }
    LDS_WAIT(); asm volatile("" ::: "memory");
    const int c = lane & 7;
#pragma unroll
    for (int j = 0; j < 4; ++j) { const int n = (lane >> 3) + 8 * j; const LAS float* s = scr + (8 * c) * 33 + n;
        v4u o; o.x = pk2(s[0 * 33], s[1 * 33]); o.y = pk2(s[2 * 33], s[3 * 33]); o.z = pk2(s[4 * 33], s[5 * 33]); o.w = pk2(s[6 * 33], s[7 * 33]);
        *(v4u*)(WT + (size_t)(drow0 + n) * ldk + koff + k0 + 8 * c) = o; }
    LDS_WAIT(); asm volatile("" ::: "memory");
}
__device__ __forceinline__ void sincos_d(double x, double& s, double& c) {
    const double k = rint(x * 0.15915494309189533577); const double r = x - k * 6.283185307179586476925; const double r2 = r * r;
    double ts = r, tc = 1.0; s = r; c = 1.0;
#pragma unroll 1
    for (int n = 1; n <= 15; ++n) { ts = -ts * r2 / (double)((2 * n) * (2 * n + 1)); tc = -tc * r2 / (double)((2 * n - 1) * (2 * n)); s += ts; c += tc; }
}
__device__ __forceinline__ const float* xrow(const float* xp, const float* xs, int m) { return m < MP ? xp + (size_t)m * DMODEL : xs + (size_t)(m - MP) * DMODEL; }

struct Args { const float* in[18]; float* out; unsigned char* ws; int ph_lo, ph_hi; };
enum { I_XP = 0, I_XS, I_PREMIX, I_WIN, I_BGATE, I_QN, I_KN, I_RPB, I_WPA, I_WPB, I_WOUT, I_POSTMIX, I_PREFFN, I_WUP, I_CW, I_CB, I_WDN, I_POSTFFN };
constexpr int NPHASE = 11;

__global__ void __launch_bounds__(NWAVES * 64, 2) enc_fwd(Args args) {
    extern __shared__ __attribute__((aligned(16))) unsigned char lds[];
    cg::grid_group grid = cg::this_grid();
    const int tid = threadIdx.x, lane = tid & 63, wave = __builtin_amdgcn_readfirstlane(tid >> 6);
    const int G = gridDim.x; const int bx = blockIdx.x; const int vcu = (G % 8 == 0) ? (bx % 8) * (G / 8) + bx / 8 : bx;
    const int gw = vcu * NWAVES + wave, NGW = G * NWAVES;
    unsigned char* ws = args.ws;
    LAS unsigned char* L = (LAS unsigned char*)lds;
    const float* xp = args.in[I_XP]; const float* xs = args.in[I_XS];
    bf16* Win_t = (bf16*)(ws + WS_WIN); bf16* Wcat_t = (bf16*)(ws + WS_WCAT); bf16* Wout_t = (bf16*)(ws + WS_WOUT); bf16* Wup_t = (bf16*)(ws + WS_WUP); bf16* Wdn_t = (bf16*)(ws + WS_WDN);
    float* TAB = (float*)(ws + WS_TAB); float* SS1 = (float*)(ws + WS_SS1); float* SS2 = (float*)(ws + WS_SS2); float* HALO = (float*)(ws + WS_HALO);
    bf16* XN = (bf16*)(ws + WS_XN); bf16* QA = (bf16*)(ws + WS_QA); bf16* KVA = (bf16*)(ws + WS_KVA); bf16* QB = (bf16*)(ws + WS_QB); bf16* KB = (bf16*)(ws + WS_KB); bf16* VB = (bf16*)(ws + WS_VB);
    bf16* GATE = (bf16*)(ws + WS_GATE); bf16* GM = (bf16*)(ws + WS_G); bf16* MIX = (bf16*)(ws + WS_MIX); bf16* ACT = (bf16*)(ws + WS_ACT);
    const int lo = args.ph_lo, hi = args.ph_hi;
#ifndef PH_MASK
#define PH_MASK 0x7ff
#endif
#define IN(k) (((PH_MASK >> (k)) & 1) && lo <= (k) && (k) < hi)
#define SEAM(k) do { if (IN(k) && IN((k) + 1)) grid.sync(); } while (0)

    if (IN(0)) {
        LAS float* scr = (LAS float*)(L + wave * 16384);
        constexpr int I_IN = 16 * 136, I_PA = 8 * 32, I_OUT = 16 * 32, I_UP = 16 * 176, I_DN = 44 * 32;
        constexpr int NITEMS = I_IN + 2 * I_PA + I_OUT + I_UP + I_DN;
        for (int it = gw; it < NITEMS; it += NGW) {
            int r = it;
            if (r < I_IN) { const int kb = r / 136, nb = r % 136; p0_transpose_item(args.in[I_WIN], DIN, Win_t, 1024, 0, 32 * nb, scr, 64 * kb, 32 * nb, lane); continue; } r -= I_IN;
            if (r < I_PA) { const int kb = r / 32, nb = r % 32; p0_transpose_item(args.in[I_WPA], 1024, Wcat_t, 1024, 0, 32 * nb, scr, 64 * kb, 32 * nb, lane); continue; } r -= I_PA;
            if (r < I_PA) { const int kb = r / 32, nb = r % 32; p0_transpose_item(args.in[I_WPB], 1024, Wcat_t, 1024, 512, 32 * nb, scr, 64 * kb, 32 * nb, lane); continue; } r -= I_PA;
            if (r < I_OUT) { const int kb = r / 32, nb = r % 32; p0_transpose_item(args.in[I_WOUT], 1024, Wout_t, 1024, 0, 32 * nb, scr, 64 * kb, 32 * nb, lane); continue; } r -= I_OUT;
            if (r < I_UP) { const int kb = r / 176, nb = r % 176; const int n0 = 32 * nb; const int nn = n0 < DFF ? n0 : n0 - DFF;
                const int drow = 256 * (nn / 128) + (n0 < DFF ? 0 : 128) + (nn % 128);
                p0_transpose_item(args.in[I_WUP], DUP, Wup_t, 1024, 0, drow, scr, 64 * kb, n0, lane); continue; } r -= I_UP;
            { const int kb = r / 32, nb = r % 32; p0_transpose_item(args.in[I_WDN], 1024, Wdn_t, DFF, 0, 32 * nb, scr, 64 * kb, 32 * nb, lane); }
        }
        { const int gid = bx * (NWAVES * 64) + tid;
          if (gid < 2048) { const int pos = gid >> 4, i = gid & 15; const float fr = exp2f(-(float)i * (13.287712379549449f / 16.0f)); const float ang = (float)pos * fr;
              double s, c; sincos_d((double)ang, s, c); TAB[gid] = (float)c; TAB[2048 + gid] = (float)s; } }
        const float* gw1 = args.in[I_PREMIX];
        for (int m = gw; m < M; m += NGW) {
            const f32x4* xr = (const f32x4*)xrow(xp, xs, m) + lane; f32x4 v[4]; float s2 = 0.f;
#pragma unroll
            for (int j = 0; j < 4; ++j) { v[j] = xr[64 * j]; s2 += (v[j].x * v[j].x + v[j].y * v[j].y) + (v[j].z * v[j].z + v[j].w * v[j].w); }
            const float rstd = 1.0f / sqrtf(wave_sum(s2) * (1.f / DMODEL) + EPS);
            v2u* o8 = (v2u*)(XN + (size_t)m * DMODEL) + lane;
#pragma unroll
            for (int j = 0; j < 4; ++j) { const f32x4 w = ((const f32x4*)gw1)[64 * j + lane]; v2u o; o.x = pk2(v[j].x * rstd * w.x, v[j].y * rstd * w.y); o.y = pk2(v[j].z * rstd * w.z, v[j].w * rstd * w.w); o8[64 * j] = o; }
        }
    }
    SEAM(0);
    if (IN(1)) {
        pg8::Gemm g{XN, Win_t, M, DIN, DMODEL, DMODEL, DMODEL}; pg8::StaticOrder S; S.init(M, DIN, G, bx);
        pg8::EpiIn E{QA, KVA, QB, KB, VB, GATE, args.in[I_BGATE]};
        pg8::gemm_phase<pg8::EpiIn, pg8::StaticOrder>(L, g, S, E);
    }
    SEAM(1);
    if (IN(2)) {
        const float* qn = args.in[I_QN]; const float* kn = args.in[I_KN];
        const int gt = (vcu * NWAVES + wave) * 64 + lane, NGT = NGW * 64;
        for (int pass = 0; pass < 2; ++pass) {
            const int total = pass == 0 ? M * 16 : M * 4;
            for (int idx = gt; idx < total; idx += NGT) {
                int row, hh, half; bf16* p; const float* nw; float osc;
                if (pass == 0) { row = idx >> 4; hh = (idx >> 1) & 7; half = idx & 1; p = QA + (size_t)row * 512 + hh * 64 + half * 32; nw = qn + half * 32; osc = 0.125f * 1.4426950408889634f; }
                else { row = idx >> 2; hh = (idx >> 1) & 1; half = idx & 1; p = KVA + (size_t)row * 256 + hh * 64 + half * 32; nw = kn + half * 32; osc = 1.0f; }
                const int t = row < MP ? (row & 2047) : ((row - MP) & 8191); const int pos = half ? (t & 63) : (t >> 6);
                v4u raw[4]; float x[32];
#pragma unroll
                for (int c = 0; c < 4; ++c) raw[c] = ((const v4u*)p)[c];
                float ss = 0.f;
#pragma unroll
                for (int c = 0; c < 4; ++c)
#pragma unroll
                    for (int e = 0; e < 4; ++e) { const unsigned w = raw[c][e]; x[c * 8 + e * 2] = pg8::bf_lo(w); x[c * 8 + e * 2 + 1] = pg8::bf_hi(w); }
#pragma unroll
                for (int i = 0; i < 32; ++i) ss += x[i] * x[i];
                ss += __shfl_xor(ss, 1);
                const float rstd = osc / sqrtf(ss * (1.f / 64.f) + EPS);
                const float* ct = TAB + pos * 16; const float* st = TAB + 2048 + pos * 16;
                float y[32];
#pragma unroll
                for (int i = 0; i < 16; ++i) { const float a = x[i] * rstd * nw[i], b = x[i + 16] * rstd * nw[i + 16]; const float c = ct[i], s = st[i];
                    y[i] = a * c - b * s; y[i + 16] = b * c + a * s; }
#pragma unroll
                for (int c = 0; c < 4; ++c) { v4u o; o.x = pk2(y[c * 8], y[c * 8 + 1]); o.y = pk2(y[c * 8 + 2], y[c * 8 + 3]); o.z = pk2(y[c * 8 + 4], y[c * 8 + 5]); o.w = pk2(y[c * 8 + 6], y[c * 8 + 7]); ((v4u*)p)[c] = o; }
            }
        }
    }
    SEAM(2);
    if (IN(3)) {
        const attn_body::bf16* Qp = (const attn_body::bf16*)QA; const attn_body::bf16* Kp = (const attn_body::bf16*)KVA; const attn_body::bf16* Vp = (const attn_body::bf16*)(KVA + 128);
        attn_body::bf16* Op = (attn_body::bf16*)XN;
        for (int u = vcu; u < 2048; u += G) { const int qb = u >> 8, bh = u & 255; attn_body::attn_unit<8>((long)(bh >> 3) * 2048, 32, bh & 7, qb * 256, Qp, Kp, Vp, Op, (char*)lds); }
        for (int u = vcu; u < 512; u += G) { const int bh = (u & 255) >> 4, qb = ((u & 15) << 1) | (u >> 8); attn_body::attn_unit<8>((long)MP + (long)(bh >> 3) * 8192, 128, bh & 7, qb * 256, Qp, Kp, Vp, Op, (char*)lds); }
        __syncthreads();
        { LAS float* rl = (LAS float*)(L + nat::RPB_OFF); const float* rpb = args.in[I_RPB]; for (int i = tid; i < 8 * 15 * 31; i += NWAVES * 64) rl[i] = rpb[i]; }
        __syncthreads();
        for (int it = gw; it < 1280 * 32; it += NGW) nat::item(QB, KB, VB, XN, (const LAS float*)(L + nat::RPB_OFF), L + wave * (2 * nat::VSLOT), it, lane);
        __syncthreads();
    }
    SEAM(3);
    if (IN(4)) {
        pg8::Gemm g{XN, Wcat_t, M, DMODEL, 512, DMODEL, DMODEL}; pg8::ChainOrder S; S.base.init(M, DMODEL, G, bx); S.seg_bytes = 1024;
        pg8::EpiMerge E{GATE, GM};
        pg8::gemm_phase<pg8::EpiMerge, pg8::ChainOrder>(L, g, S, E);
    }
    SEAM(4);
    if (IN(5)) {
        pg8::Gemm g{GM, Wout_t, M, DMODEL, DMODEL, DMODEL, DMODEL}; pg8::StaticOrder S; S.init(M, DMODEL, G, bx);
        pg8::EpiSS E{MIX, SS1};
        pg8::gemm_phase<pg8::EpiSS, pg8::StaticOrder>(L, g, S, E);
    }
    SEAM(5);
    if (IN(6)) {
        const f32x4* w1 = (const f32x4*)args.in[I_POSTMIX]; const f32x4* w2 = (const f32x4*)args.in[I_PREFFN];
        for (int m = gw; m < M; m += NGW) {
            const f32x4* sp = (const f32x4*)(SS1 + (size_t)m * 16); const f32x4 a = sp[0], b = sp[1], c = sp[2], d = sp[3];
            const float ss = ((a.x + a.y) + (a.z + a.w)) + ((b.x + b.y) + (b.z + b.w)) + ((c.x + c.y) + (c.z + c.w)) + ((d.x + d.y) + (d.z + d.w));
            const float rstd = 1.0f / sqrtf(ss * (1.f / DMODEL) + EPS);
            const f32x4* xr = (const f32x4*)xrow(xp, xs, m) + lane; const v2u* mr = (const v2u*)(MIX + (size_t)m * DMODEL) + lane; f32x4* orow = (f32x4*)(args.out + (size_t)m * DMODEL) + lane;
            f32x4 v[4]; float s2 = 0.f;
#pragma unroll
            for (int j = 0; j < 4; ++j) { const v2u mw = mr[64 * j]; const f32x4 w = w1[64 * j + lane]; const f32x4 x = xr[64 * j];
                v[j].x = x.x + pg8::bf_lo(mw.x) * rstd * w.x; v[j].y = x.y + pg8::bf_hi(mw.x) * rstd * w.y; v[j].z = x.z + pg8::bf_lo(mw.y) * rstd * w.z; v[j].w = x.w + pg8::bf_hi(mw.y) * rstd * w.w;
                orow[64 * j] = v[j]; s2 += (v[j].x * v[j].x + v[j].y * v[j].y) + (v[j].z * v[j].z + v[j].w * v[j].w); }
            const float rstd2 = 1.0f / sqrtf(wave_sum(s2) * (1.f / DMODEL) + EPS);
            v2u* o8 = (v2u*)(XN + (size_t)m * DMODEL) + lane;
#pragma unroll
            for (int j = 0; j < 4; ++j) { const f32x4 w = w2[64 * j + lane]; v2u o; o.x = pk2(v[j].x * rstd2 * w.x, v[j].y * rstd2 * w.y); o.y = pk2(v[j].z * rstd2 * w.z, v[j].w * rstd2 * w.w); o8[64 * j] = o; }
        }
    }
    SEAM(6);
    if (IN(7)) {
        pg8::Gemm g{XN, Wup_t, M, DUP, DMODEL, DMODEL, DMODEL}; pg8::StaticOrder S; S.init(M, DUP, G, bx);
        pg8::EpiConv E{ACT, HALO, args.in[I_CW], args.in[I_CB]};
        pg8::gemm_phase<pg8::EpiConv, pg8::StaticOrder>(L, g, S, E);
    }
    SEAM(7);
    if (IN(8)) {
        const float* cw = args.in[I_CW]; const float* cb = args.in[I_CB];
        const int gt = (vcu * NWAVES + wave) * 64 + lane, NGT = NGW * 64;
        for (int idx = gt; idx < 320 * 2 * DFF; idx += NGT) {
            const int ca = idx % DFF, e = (idx / DFF) & 1, pm = idx / (2 * DFF);
            const int hc = (ca >> 7) * 256 + (ca & 127);
            const bool seq_first = pm < 256 ? (pm & 7) == 0 : ((pm - 256) & 31) == 0;
            const bool seq_last = pm < 256 ? (pm & 7) == 7 : ((pm - 256) & 31) == 31;
            const float* hp = HALO + (size_t)pm * 4 * 5632;
            float cv[2];
#pragma unroll
            for (int bj = 0; bj < 2; ++bj) { const int c = hc + bj * 128; float up, cur, dn;
                if (e == 0) { up = seq_first ? 0.f : hp[-5632 + c]; cur = hp[c]; dn = hp[5632 + c]; }
                else { up = hp[2 * 5632 + c]; cur = hp[3 * 5632 + c]; dn = seq_last ? 0.f : hp[4 * 5632 + c]; }
                const int wc = bj * DFF + ca;
                cv[bj] = cw[wc] * up + cw[DUP + wc] * cur + cw[2 * DUP + wc] * dn + cb[wc]; }
            const float o = pg8::gelu_tanh_f(cv[0]) * cv[1];
            ACT[(size_t)(pm * 256 + (e ? 255 : 0)) * DFF + ca] = (bf16)(pk2(o, 0.f) & 0xffffu);
        }
    }
    SEAM(8);
    if (IN(9)) {
        pg8::Gemm g{ACT, Wdn_t, M, DMODEL, DFF, DFF, DFF}; pg8::StaticOrder S; S.init(M, DMODEL, G, bx);
        pg8::EpiSS E{MIX, SS2};
        pg8::gemm_phase<pg8::EpiSS, pg8::StaticOrder>(L, g, S, E);
    }
    SEAM(9);
    if (IN(10)) {
        const f32x4* w1 = (const f32x4*)args.in[I_POSTFFN];
        for (int m = gw; m < M; m += NGW) {
            const f32x4* sp = (const f32x4*)(SS2 + (size_t)m * 16); const f32x4 a = sp[0], b = sp[1], c = sp[2], d = sp[3];
            const float ss = ((a.x + a.y) + (a.z + a.w)) + ((b.x + b.y) + (b.z + b.w)) + ((c.x + c.y) + (c.z + c.w)) + ((d.x + d.y) + (d.z + d.w));
            const float rstd = 1.0f / sqrtf(ss * (1.f / DMODEL) + EPS);
            const v2u* mr = (const v2u*)(MIX + (size_t)m * DMODEL) + lane; f32x4* orow = (f32x4*)(args.out + (size_t)m * DMODEL) + lane;
#pragma unroll
            for (int j = 0; j < 4; ++j) { const v2u mw = mr[64 * j]; const f32x4 w = w1[64 * j + lane]; f32x4 x = orow[64 * j];
                x.x += pg8::bf_lo(mw.x) * rstd * w.x; x.y += pg8::bf_hi(mw.x) * rstd * w.y; x.z += pg8::bf_lo(mw.y) * rstd * w.z; x.w += pg8::bf_hi(mw.y) * rstd * w.w;
                orow[64 * j] = x; }
        }
    }
#undef IN
#undef SEAM
}

#ifndef MK_N_LAUNCHES
#define MK_N_LAUNCHES 1
#endif
extern "C" void kernel_launch(void* const* d_in, const int* in_sizes, int n_in, void* d_out, int out_size, void* d_ws, size_t ws_size, hipStream_t stream) {
    static int grid = 0;
    if (grid == 0) {
        if (n_in != 18 || in_sizes[0] != MP * DMODEL || out_size != M * DMODEL || ws_size < WS_END) { fprintf(stderr, "kernel_launch: unexpected shapes (n_in %d, in0 %d, out %d, ws %zu); nothing launched\n", n_in, n_in > 0 ? in_sizes[0] : -1, out_size, ws_size); grid = -1; return; }
        int dev = 0, cus = 0, per_cu = 0;
        if (hipGetDevice(&dev) != hipSuccess || hipDeviceGetAttribute(&cus, hipDeviceAttributeMultiprocessorCount, dev) != hipSuccess) { grid = -1; return; }
        if (hipFuncSetAttribute((const void*)enc_fwd, hipFuncAttributeMaxDynamicSharedMemorySize, LDS_BYTES) != hipSuccess) { fprintf(stderr, "kernel_launch: hipFuncSetAttribute failed\n"); grid = -1; return; }
        if (hipOccupancyMaxActiveBlocksPerMultiprocessor(&per_cu, (const void*)enc_fwd, NWAVES * 64, LDS_BYTES) != hipSuccess || per_cu < 1) { fprintf(stderr, "kernel_launch: occupancy query gave %d\n", per_cu); per_cu = 1; }
        (void)hipGetLastError();
        grid = cus * per_cu;
    }
    if (grid < 0) return;
    Args a{};
    for (int i = 0; i < 18; ++i) a.in[i] = (const float*)d_in[i];
    a.out = (float*)d_out; a.ws = (unsigned char*)d_ws;
#if MK_N_LAUNCHES == 1
    a.ph_lo = 0; a.ph_hi = NPHASE;
    void* kargs[] = {&a};
    const hipError_t e = hipLaunchCooperativeKernel((const void*)enc_fwd, dim3(grid), dim3(NWAVES * 64), kargs, LDS_BYTES, stream);
    if (e != hipSuccess) fprintf(stderr, "kernel_launch: cooperative launch failed: %s (grid %d)\n", hipGetErrorString(e), grid);
#else
    for (int p = 0; p < NPHASE; ++p) { a.ph_lo = p; a.ph_hi = p + 1; hipLaunchKernelGGL(enc_fwd, dim3(grid), dim3(NWAVES * 64), LDS_BYTES, stream, a); }
#endif
}
```

```cpp
#include <hip/hip_runtime.h>
#include <hip/hip_cooperative_groups.h>
#include <hip/hip_bf16.h>
#include <cstdio>
#include <cstdint>
#include <cmath>
namespace cg = cooperative_groups;
namespace pg8 {
#define PG8_LAS __attribute__((address_space(3)))
typedef unsigned short bf16_t;
typedef short bf16x8 __attribute__((ext_vector_type(8)));
typedef float f32x4 __attribute__((ext_vector_type(4)));
typedef unsigned u32x4 __attribute__((ext_vector_type(4)));
constexpr int BM = 256, BK = 64, HALF = 128, HTB = HALF * BK * 2  , STAGE_BYTES = 8 * HTB, NXCD = 8, WGM = 8;

__host__ __device__ __forceinline__ int lds_byte(int r, int c) { const int st = (r >> 4) * 2 + (c >> 5), rr = r & 15, cc = c & 31, ob = rr * 64 + cc * 2; return st * 1024 + (ob ^ (((ob >> 9) & 1) << 5)); }
__host__ __device__ __forceinline__ void stage_rc(int b, int& R, int& C) { const int st = b / 1024, sb = b % 1024, swz = sb ^ (((sb >> 9) & 1) << 5); R = (st >> 1) * 16 + swz / 64; C = (st & 1) * 32 + (swz % 64) / 2; }
__host__ __device__ __forceinline__ int perm32(int rho) { const int n = rho >> 4, i = rho & 15; return 8 * (i >> 2) + 4 * n + (i & 3); }

struct Unit { int pm, pn, ko; };
struct Gemm { const bf16_t* A; const bf16_t* Bt; int M, N, K, lda, ldb; };

struct StaticOrder {
    int nM, nN, nwg, G, c;
    __host__ __device__ void init(int M, int N, int G_, int c_) { nM = M / BM; nN = N / BM; nwg = nM * nN; G = G_; c = c_; }
    __host__ __device__ bool next(int i, Unit& u) const {
        const long L = (long)i * G + c; if (L >= nwg) return false;
        int wgid = (int)L; { const int q = nwg / NXCD, r = nwg % NXCD, xcd = wgid % NXCD, off = wgid / NXCD; wgid = (xcd < r ? xcd * (q + 1) : r * (q + 1) + (xcd - r) * q) + off; }
        const int nig = WGM * nN, gid = wgid / nig, fm = gid * WGM, gsz = (nM - fm) < WGM ? (nM - fm) : WGM;
        u.pm = fm + ((wgid % nig) % gsz); u.pn = (wgid % nig) / gsz; u.ko = 0; return true;
    }
    __device__ __forceinline__ void a_ready(const Unit&) const {}
    __device__ __forceinline__ void done(const Unit&) const {}
};
struct ChainOrder {
    StaticOrder base; int seg_bytes;
    __host__ __device__ bool next(int i, Unit& u) const { const bool ok = base.next(i >> 1, u); u.ko = (i & 1) * seg_bytes; return ok; }
    __device__ __forceinline__ void a_ready(const Unit&) const {}
    __device__ __forceinline__ void done(const Unit&) const {}
};

__device__ __forceinline__ unsigned cvt_pk_bf16(float lo, float hi) { unsigned r; asm volatile("v_cvt_pk_bf16_f32 %0, %1, %2" : "=v"(r) : "v"(lo), "v"(hi)); return r; }
typedef float f32x2 __attribute__((ext_vector_type(2)));
__device__ __forceinline__ float bf_lo(unsigned w) { return __uint_as_float(w << 16); }
__device__ __forceinline__ float bf_hi(unsigned w) { return __uint_as_float(w & 0xffff0000u); }
__device__ __forceinline__ float sigmoid_f(float z) { return __builtin_amdgcn_rcpf(1.0f + __builtin_amdgcn_exp2f(-1.4426950408889634f * z)); }
__device__ __forceinline__ float gelu_tanh_f(float x) {
    const float t = x * (1.0f + 0.044715f * x * x);
    return x * __builtin_amdgcn_rcpf(1.0f + __builtin_amdgcn_exp2f(-2.302208198f * t));
}
__device__ __forceinline__ u32x4 pack8(const f32x4 v0, const f32x4 v1) { u32x4 w; w.x = cvt_pk_bf16(v0[0], v0[1]); w.y = cvt_pk_bf16(v0[2], v0[3]); w.z = cvt_pk_bf16(v1[0], v1[1]); w.w = cvt_pk_bf16(v1[2], v1[3]); return w; }

struct EpiIn {
    static constexpr bool PERM = true, AFTER_DRAIN = false, CHAIN = false;
    bf16_t *QA, *KVA, *QB, *KB, *VB, *GATE; const float* bgate; const float* qn; const float* kn; const float* tab;
    __device__ __forceinline__ void operator()(const f32x4 (&acc)[2][2][4][2], const Unit& u, int wr, int wc, int fr, int fq, PG8_LAS unsigned char*) const {
        const int pn = u.pn; bf16_t* base; int ldc, colt; bool sig = false; float osc = 1.0f;
        if (pn < 2) { base = QA; ldc = 512; colt = pn * 256; }
        else if (pn == 2) { base = KVA; ldc = 256; colt = 0; }
        else if (pn < 5) { base = QB; ldc = 512; colt = (pn - 3) * 256; osc = 0.125f * 1.4426950408889634f; }
        else if (pn < 7) { base = KB; ldc = 512; colt = (pn - 5) * 256; }
        else if (pn < 9) { base = VB; ldc = 512; colt = (pn - 7) * 256; }
        else { base = GATE; ldc = 2048; colt = (pn - 9) * 256; sig = true; }
        const int row0 = u.pm * BM + wr * 64 + fr, col0 = colt + wc * 32 + 8 * fq;
        f32x4 bv[2][2];
#pragma unroll
        for (int bj = 0; bj < 2; ++bj)
#pragma unroll
            for (int n = 0; n < 2; ++n) bv[bj][n] = sig ? *(const f32x4*)(bgate + col0 + bj * HALF + 4 * n) : (f32x4){0.f, 0.f, 0.f, 0.f};
#pragma unroll
        for (int ai = 0; ai < 2; ++ai)
#pragma unroll
            for (int m = 0; m < 4; ++m) { bf16_t* rowp = base + (size_t)(row0 + ai * HALF + m * 16) * ldc + col0;
#pragma unroll
                for (int bj = 0; bj < 2; ++bj) { f32x4 v0 = acc[ai][bj][m][0] + bv[bj][0], v1 = acc[ai][bj][m][1] + bv[bj][1];
                    if (sig) {
#pragma unroll
                        for (int i = 0; i < 4; ++i) { v0[i] = sigmoid_f(v0[i]); v1[i] = sigmoid_f(v1[i]); } }
                    *(u32x4*)(rowp + bj * HALF) = pack8(v0 * osc, v1 * osc); } }
        if (pn > 2) return;
        asm volatile("s_waitcnt vmcnt(0)" ::: "memory"); __builtin_amdgcn_s_barrier(); asm volatile("" ::: "memory");
        const int nh = pn == 2 ? 2 : 4; const float* nw0 = pn == 2 ? kn : qn; const float sc = pn == 2 ? 1.0f : 0.125f * 1.4426950408889634f;
        for (int idx = threadIdx.x; idx < 256 * nh * 2; idx += 1024) {
            u32x4 raw[2][4]; bf16_t* p[2]; int pos[2]; float ss[2];
#pragma unroll
            for (int k = 0; k < 2; ++k) { const int id = idx + 512 * k; const int half = id & 1, hh = (id >> 1) & (nh - 1), r = pn == 2 ? (id >> 2) : (id >> 3); const int row = u.pm * BM + r;
                p[k] = base + (size_t)row * ldc + colt + hh * 64 + half * 32;
                const int t = row < 65536 ? (row & 2047) : ((row - 65536) & 8191); pos[k] = half ? (t & 63) : (t >> 6);
#pragma unroll
                for (int c = 0; c < 4; ++c) raw[k][c] = ((const u32x4*)p[k])[c]; }
            const float* nw = nw0 + (idx & 1) * 32;
            f32x4 nwv[8];
#pragma unroll
            for (int c = 0; c < 8; ++c) nwv[c] = ((const f32x4*)nw)[c];
#pragma unroll
            for (int k = 0; k < 2; ++k) {
                f32x4 ct[4], st[4];
#pragma unroll
                for (int c = 0; c < 4; ++c) { ct[c] = ((const f32x4*)(tab + pos[k] * 16))[c]; st[c] = ((const f32x4*)(tab + 2048 + pos[k] * 16))[c]; }
                float x[32]; float s2 = 0.f;
#pragma unroll
                for (int c = 0; c < 4; ++c)
#pragma unroll
                    for (int e = 0; e < 4; ++e) { const unsigned w = raw[k][c][e]; x[c * 8 + e * 2] = bf_lo(w); x[c * 8 + e * 2 + 1] = bf_hi(w); }
#pragma unroll
                for (int i = 0; i < 32; ++i) s2 += x[i] * x[i];
                s2 += __shfl_xor(s2, 1);
                const float rstd = sc / sqrtf(s2 * (1.f / 64.f) + 1e-6f);
                float y[32];
#pragma unroll
                for (int i = 0; i < 16; ++i) { const float a = x[i] * rstd * nwv[i >> 2][i & 3], b = x[i + 16] * rstd * nwv[4 + (i >> 2)][i & 3]; const float c = ct[i >> 2][i & 3], sn = st[i >> 2][i & 3];
                    y[i] = a * c - b * sn; y[i + 16] = b * c + a * sn; }
#pragma unroll
                for (int c = 0; c < 4; ++c) { u32x4 o; o.x = cvt_pk_bf16(y[c * 8], y[c * 8 + 1]); o.y = cvt_pk_bf16(y[c * 8 + 2], y[c * 8 + 3]); o.z = cvt_pk_bf16(y[c * 8 + 4], y[c * 8 + 5]); o.w = cvt_pk_bf16(y[c * 8 + 6], y[c * 8 + 7]); ((u32x4*)p[k])[c] = o; }
            }
        }
    }
};

struct EpiMerge {
    static constexpr bool PERM = true, AFTER_DRAIN = false, CHAIN = true;
    const bf16_t* GATE; bf16_t* G;
    __device__ __forceinline__ void mid(f32x4 (&acc)[2][2][4][2], const Unit& u, int wr, int wc, int fr, int fq) const {
        const int row0 = u.pm * BM + wr * 64 + fr, col0 = u.pn * BM + wc * 32 + 8 * fq;
#pragma unroll
        for (int ai = 0; ai < 2; ++ai)
#pragma unroll
            for (int m = 0; m < 4; ++m) { const bf16_t* gp = GATE + (size_t)(row0 + ai * HALF + m * 16) * 2048 + col0;
#pragma unroll
                for (int bj = 0; bj < 2; ++bj) { const u32x4 ga = *(const u32x4*)(gp + bj * HALF), gb = *(const u32x4*)(gp + 1024 + bj * HALF);
#pragma unroll
                    for (int n = 0; n < 2; ++n) { const unsigned a0 = n ? ga.z : ga.x, a1 = n ? ga.w : ga.y, b0 = n ? gb.z : gb.x, b1 = n ? gb.w : gb.y;
                        f32x4 r; r[0] = bf_lo(a0) * __builtin_amdgcn_rcpf(bf_lo(b0)); r[1] = bf_hi(a0) * __builtin_amdgcn_rcpf(bf_hi(b0));
                        r[2] = bf_lo(a1) * __builtin_amdgcn_rcpf(bf_lo(b1)); r[3] = bf_hi(a1) * __builtin_amdgcn_rcpf(bf_hi(b1));
                        acc[ai][bj][m][n] = acc[ai][bj][m][n] * r; } }
                if (m == 3) asm volatile("" ::: "memory"); }
    }
    __device__ __forceinline__ void operator()(f32x4 (&acc)[2][2][4][2], const Unit& u, int wr, int wc, int fr, int fq, PG8_LAS unsigned char*) const {
        if (u.ko == 0) { mid(acc, u, wr, wc, fr, fq); return; }
        const int row0 = u.pm * BM + wr * 64 + fr, col0 = u.pn * BM + wc * 32 + 8 * fq;
#pragma unroll
        for (int ai = 0; ai < 2; ++ai)
#pragma unroll
            for (int m = 0; m < 4; ++m) { const size_t r = (size_t)(row0 + ai * HALF + m * 16);
#pragma unroll
                for (int bj = 0; bj < 2; ++bj) { const u32x4 gb = *(const u32x4*)(GATE + r * 2048 + 1024 + col0 + bj * HALF);
                    f32x4 v0 = acc[ai][bj][m][0], v1 = acc[ai][bj][m][1];
                    v0[0] *= bf_lo(gb.x); v0[1] *= bf_hi(gb.x); v0[2] *= bf_lo(gb.y); v0[3] *= bf_hi(gb.y);
                    v1[0] *= bf_lo(gb.z); v1[1] *= bf_hi(gb.z); v1[2] *= bf_lo(gb.w); v1[3] *= bf_hi(gb.w);
                    *(u32x4*)(G + r * 1024 + col0 + bj * HALF) = pack8(v0, v1); } }
    }
};

struct EpiSS {
    static constexpr bool PERM = true, AFTER_DRAIN = false, CHAIN = false;
    bf16_t* O; float* SS;
    __device__ __forceinline__ void operator()(const f32x4 (&acc)[2][2][4][2], const Unit& u, int wr, int wc, int fr, int fq, PG8_LAS unsigned char*) const {
        const int row0 = u.pm * BM + wr * 64 + fr, col0 = u.pn * BM + wc * 32 + 8 * fq;
#pragma unroll
        for (int ai = 0; ai < 2; ++ai)
#pragma unroll
            for (int m = 0; m < 4; ++m) { const size_t r = (size_t)(row0 + ai * HALF + m * 16); float s = 0.f;
#pragma unroll
                for (int bj = 0; bj < 2; ++bj) { const f32x4 v0 = acc[ai][bj][m][0], v1 = acc[ai][bj][m][1];
                    s += (v0[0] * v0[0] + v0[1] * v0[1]) + (v0[2] * v0[2] + v0[3] * v0[3]) + (v1[0] * v1[0] + v1[1] * v1[1]) + (v1[2] * v1[2] + v1[3] * v1[3]);
                    *(u32x4*)(O + r * 1024 + col0 + bj * HALF) = pack8(v0, v1); }
                s += __shfl_xor(s, 16); s += __shfl_xor(s, 32);
                if (fq == 0) SS[r * 16 + u.pn * 4 + wc] = s; }
    }
};

struct RowExchange {
    unsigned long long* xs;
    __device__ __forceinline__ void run(const float (&ps)[2][4], float (&rs)[2][4], const Unit& u, int wr, int wc, int fr, int fq, PG8_LAS unsigned char* lds) const {
        PG8_LAS float* P = (PG8_LAS float*)(lds + 131072); PG8_LAS float* R = P + 1024;
        const int tid = threadIdx.x;
#pragma unroll
        for (int ai = 0; ai < 2; ++ai)
#pragma unroll
            for (int m = 0; m < 4; ++m) { float t = ps[ai][m]; t += __shfl_xor(t, 16); t += __shfl_xor(t, 32); if (fq == 0) P[(ai * HALF + wr * 64 + m * 16 + fr) * 4 + wc] = t; }
        asm volatile("s_waitcnt lgkmcnt(0)" ::: "memory"); __builtin_amdgcn_s_barrier(); asm volatile("" ::: "memory");
        if (tid < 256) { const f32x4 p = *(const PG8_LAS f32x4*)(P + tid * 4); const float mine = (p[0] + p[1]) + (p[2] + p[3]);
            unsigned long long* sl = xs + ((size_t)u.pm * BM + tid) * 4;
            __hip_atomic_store(sl + u.pn, ((unsigned long long)1u << 32) | (unsigned long long)__float_as_uint(mine), __ATOMIC_RELAXED, __HIP_MEMORY_SCOPE_AGENT);
            float tot = 0.f; unsigned got = 0u; unsigned spins = 0;
            while (got != 15u) {
#pragma unroll
                for (int t = 0; t < 4; ++t) if (!((got >> t) & 1u)) { const unsigned long long v = __hip_atomic_load(sl + t, __ATOMIC_RELAXED, __HIP_MEMORY_SCOPE_AGENT);
                    if ((unsigned)(v >> 32) == 1u) { tot += __uint_as_float((unsigned)v); got |= 1u << t; } }
                if (got != 15u) { __builtin_amdgcn_s_sleep(1); if (++spins > (1u << 20)) break; } }
            R[tid] = 1.0f / sqrtf(tot * (1.f / 1024.f) + 1e-6f); }
        asm volatile("s_waitcnt vmcnt(0) lgkmcnt(0)" ::: "memory"); __builtin_amdgcn_s_barrier(); asm volatile("" ::: "memory");
#pragma unroll
        for (int ai = 0; ai < 2; ++ai)
#pragma unroll
            for (int m = 0; m < 4; ++m) rs[ai][m] = R[ai * HALF + wr * 64 + m * 16 + fr];
    }
};
__device__ __forceinline__ float sq4(const f32x4 v) { return (v[0] * v[0] + v[1] * v[1]) + (v[2] * v[2] + v[3] * v[3]); }
template <int MODE> struct EpiNorm {
    static constexpr bool PERM = true, AFTER_DRAIN = false, CHAIN = false;
    RowExchange ex1, ex2; const float* xp; const float* xs; float* out; const float* w1; const float* w2; bf16_t* XN2; bf16_t* X1B;
    __device__ __forceinline__ void operator()(f32x4 (&acc)[2][2][4][2], const Unit& u, int wr, int wc, int fr, int fq, PG8_LAS unsigned char* lds) const {
        const int row0 = u.pm * BM + wr * 64 + fr, col0 = u.pn * BM + wc * 32 + 8 * fq;
        float ps[2][4], rs[2][4];
#pragma unroll
        for (int ai = 0; ai < 2; ++ai)
#pragma unroll
            for (int m = 0; m < 4; ++m) ps[ai][m] = (sq4(acc[ai][0][m][0]) + sq4(acc[ai][0][m][1])) + (sq4(acc[ai][1][m][0]) + sq4(acc[ai][1][m][1]));
        u32x4 prb[4][2];
        if (MODE == 1) { const bf16_t* xb0 = X1B + (size_t)u.pm * BM * 1024;
#pragma unroll
            for (int m = 0; m < 4; ++m)
#pragma unroll
                for (int bj = 0; bj < 2; ++bj) prb[m][bj] = *(const u32x4*)(xb0 + (size_t)(wr * 64 + fr + m * 16) * 1024 + col0 + bj * HALF); }
        ex1.run(ps, rs, u, wr, wc, fr, fq, lds);
        const float* xin = xp; if (MODE == 0) xin = u.pm < 256 ? xp + (size_t)u.pm * BM * 1024 : xs + (size_t)(u.pm - 256) * BM * 1024;
        float* xo = out + (size_t)u.pm * BM * 1024; bf16_t* xb = X1B + (size_t)u.pm * BM * 1024;
        const int lr0 = wr * 64 + fr;
        f32x4 wv[2][2];
#pragma unroll
        for (int bj = 0; bj < 2; ++bj)
#pragma unroll
            for (int n = 0; n < 2; ++n) wv[bj][n] = *(const f32x4*)(w1 + col0 + bj * HALF + 4 * n);
#pragma unroll
        for (int ai = 0; ai < 2; ++ai)
#pragma unroll
            for (int m = 0; m < 4; ++m) { const size_t ro = (size_t)(lr0 + ai * HALF + m * 16) * 1024 + col0; const float r1 = rs[ai][m]; float s2 = 0.f;
#pragma unroll
                for (int bj = 0; bj < 2; ++bj) {
                    if (MODE == 0) { const f32x4 x0 = *(const f32x4*)(xin + ro + bj * HALF), x1 = *(const f32x4*)(xin + ro + bj * HALF + 4);
                        const f32x4 v0 = x0 + acc[ai][bj][m][0] * r1 * wv[bj][0], v1 = x1 + acc[ai][bj][m][1] * r1 * wv[bj][1];
                        acc[ai][bj][m][0] = v0; acc[ai][bj][m][1] = v1; s2 += sq4(v0) + sq4(v1);
                        *(u32x4*)(xb + ro + bj * HALF) = pack8(v0, v1);
                    } else { const u32x4 rw = ai == 0 ? prb[m][bj] : *(const u32x4*)(xb + ro + bj * HALF);
                        const f32x4 x0 = (f32x4){bf_lo(rw.x), bf_hi(rw.x), bf_lo(rw.y), bf_hi(rw.y)}, x1 = (f32x4){bf_lo(rw.z), bf_hi(rw.z), bf_lo(rw.w), bf_hi(rw.w)};
                        *(f32x4*)(xo + ro + bj * HALF) = x0 + acc[ai][bj][m][0] * r1 * wv[bj][0];
                        *(f32x4*)(xo + ro + bj * HALF + 4) = x1 + acc[ai][bj][m][1] * r1 * wv[bj][1]; } }
                ps[ai][m] = s2;
                if (MODE == 0 && m == 3) asm volatile("" ::: "memory"); }
        if (MODE == 0) {
            ex2.run(ps, rs, u, wr, wc, fr, fq, lds);
#pragma unroll
            for (int bj = 0; bj < 2; ++bj)
#pragma unroll
                for (int n = 0; n < 2; ++n) wv[bj][n] = *(const f32x4*)(w2 + col0 + bj * HALF + 4 * n);
#pragma unroll
            for (int ai = 0; ai < 2; ++ai)
#pragma unroll
                for (int m = 0; m < 4; ++m) { const size_t ro = (size_t)(row0 + ai * HALF + m * 16) * 1024 + col0; const float r2 = rs[ai][m];
#pragma unroll
                    for (int bj = 0; bj < 2; ++bj) *(u32x4*)(XN2 + ro + bj * HALF) = pack8(acc[ai][bj][m][0] * r2 * wv[bj][0], acc[ai][bj][m][1] * r2 * wv[bj][1]); }
        }
    }
};

constexpr int EDGE_OFF = 131072;
__device__ __forceinline__ float dpp_shr1(float old, float src) { return __int_as_float(__builtin_amdgcn_update_dpp(__float_as_int(old), __float_as_int(src), 0x111, 0xF, 0xF, false)); }
__device__ __forceinline__ float dpp_shl1(float old, float src) { return __int_as_float(__builtin_amdgcn_update_dpp(__float_as_int(old), __float_as_int(src), 0x101, 0xF, 0xF, false)); }
__device__ __forceinline__ float dpp_ror1(float src) { return __int_as_float(__builtin_amdgcn_mov_dpp(__float_as_int(src), 0x121, 0xF, 0xF, false)); }
__device__ __forceinline__ float dpp_ror15(float src) { return __int_as_float(__builtin_amdgcn_mov_dpp(__float_as_int(src), 0x12F, 0xF, 0xF, false)); }
struct EpiConv {
    static constexpr bool PERM = true, AFTER_DRAIN = false, CHAIN = false;
    bf16_t* ACT; float* HALO; const float* cw; const float* cb;
    __device__ __forceinline__ void operator()(const f32x4 (&acc)[2][2][4][2], const Unit& u, int wr, int wc, int fr, int fq, PG8_LAS unsigned char* lds) const {
        PG8_LAS float* edge = (PG8_LAS float*)(lds + EDGE_OFF);
        const int lc0 = wc * 32 + 8 * fq;
#pragma unroll
        for (int ai = 0; ai < 2; ++ai)
#pragma unroll
            for (int bj = 0; bj < 2; ++bj)
#pragma unroll
                for (int n = 0; n < 2; ++n) { const int lc = bj * HALF + lc0 + 4 * n;
                    if (fr == 0) *(PG8_LAS f32x4*)(edge + ((ai * 2 + wr) * 2 + 0) * 256 + lc) = acc[ai][bj][0][n];
                    if (fr == 15) *(PG8_LAS f32x4*)(edge + ((ai * 2 + wr) * 2 + 1) * 256 + lc) = acc[ai][bj][3][n]; }
        { float* hp = HALO + (size_t)u.pm * 4 * 5632 + u.pn * 256;
          if (wr == 0 && fr < 2) {
#pragma unroll
            for (int bj = 0; bj < 2; ++bj)
#pragma unroll
                for (int n = 0; n < 2; ++n) *(f32x4*)(hp + (size_t)fr * 5632 + bj * HALF + lc0 + 4 * n) = acc[0][bj][0][n]; }
          if (wr == 1 && fr >= 14) {
#pragma unroll
            for (int bj = 0; bj < 2; ++bj)
#pragma unroll
                for (int n = 0; n < 2; ++n) *(f32x4*)(hp + (size_t)(fr - 12) * 5632 + bj * HALF + lc0 + 4 * n) = acc[1][bj][3][n]; } }
        asm volatile("s_waitcnt lgkmcnt(0)" ::: "memory"); __builtin_amdgcn_s_barrier(); asm volatile("" ::: "memory");
        const int row0 = u.pm * BM + wr * 64 + fr;
#pragma unroll
        for (int n = 0; n < 2; ++n) {
            const int oc = u.pn * HALF + lc0 + 4 * n;
            f32x4 W[2][3], Bc[2];
#pragma unroll
            for (int bj = 0; bj < 2; ++bj) { Bc[bj] = *(const f32x4*)(cb + bj * 2816 + oc);
#pragma unroll
                for (int j = 0; j < 3; ++j) W[bj][j] = *(const f32x4*)(cw + (size_t)j * 5632 + bj * 2816 + oc); }
#pragma unroll
            for (int ai = 0; ai < 2; ++ai) {
                const int blk = ai * 2 + wr;
                f32x4 cv[2][4];
#pragma unroll
                for (int bj = 0; bj < 2; ++bj) { const int lc = bj * HALF + lc0 + 4 * n;
                    const f32x4 eup = blk > 0 ? *(const PG8_LAS f32x4*)(edge + ((blk - 1) * 2 + 1) * 256 + lc) : (f32x4){0.f, 0.f, 0.f, 0.f};
                    const f32x4 edn = blk < 3 ? *(const PG8_LAS f32x4*)(edge + ((blk + 1) * 2 + 0) * 256 + lc) : (f32x4){0.f, 0.f, 0.f, 0.f};
                    f32x4 T[4], S[4];
#pragma unroll
                    for (int m = 0; m < 4; ++m)
#pragma unroll
                        for (int i = 0; i < 4; ++i) { T[m][i] = dpp_ror1(acc[ai][bj][m][n][i]); S[m][i] = dpp_ror15(acc[ai][bj][m][n][i]); }
#pragma unroll
                    for (int m = 0; m < 4; ++m) { const f32x4 cur = acc[ai][bj][m][n]; const f32x4 tp = m > 0 ? T[m > 0 ? m - 1 : 0] : eup, sn = m < 3 ? S[m < 3 ? m + 1 : 3] : edn;
#pragma unroll
                        for (int i = 0; i < 4; ++i) { const float up = fr == 0 ? tp[i] : T[m][i], dn = fr == 15 ? sn[i] : S[m][i];
                            cv[bj][m][i] = W[bj][0][i] * up + W[bj][1][i] * cur[i] + W[bj][2][i] * dn + Bc[bj][i]; } } }
#pragma unroll
                for (int m = 0; m < 4; ++m) { typedef unsigned u32x2v __attribute__((ext_vector_type(2))); u32x2v w;
                    w.x = cvt_pk_bf16(gelu_tanh_f(cv[0][m][0]) * cv[1][m][0], gelu_tanh_f(cv[0][m][1]) * cv[1][m][1]);
                    w.y = cvt_pk_bf16(gelu_tanh_f(cv[0][m][2]) * cv[1][m][2], gelu_tanh_f(cv[0][m][3]) * cv[1][m][3]);
                    *(u32x2v*)(ACT + (size_t)(row0 + ai * HALF + m * 16) * 2816 + oc) = w; } } }
    }
};
template <class Epi, class Sched, bool ALIGN_EPI = true, bool SP2 = true>
__device__ __forceinline__ void gemm_phase(PG8_LAS unsigned char* lds, const Gemm g, const Sched& S, const Epi& E) {
    const int tid = threadIdx.x, wid = __builtin_amdgcn_readfirstlane(tid >> 6), lane = tid & 63, wr = wid >> 2, wc = wid & 3, fr = lane & 15, fq = lane >> 4;
    const int K = g.K, nt = K / BK;
    unsigned voffA[2], voffB[2];
#pragma unroll
    for (int i = 0; i < 2; ++i) { int R, C; stage_rc(tid * 16 + i * 8192, R, C); const int Rb = Epi::PERM ? ((R & ~31) + perm32(R & 31)) : R;
        voffA[i] = (unsigned)(R * g.lda + C) * 2u; voffB[i] = (unsigned)(Rb * g.ldb + C) * 2u; }
    const size_t kstep = (size_t)(BK * 2);
    const size_t hstepA = (size_t)HALF * g.lda * 2, hstepB = (size_t)HALF * g.ldb * 2;
    const size_t tstepA = 2 * hstepA, tstepB = 2 * hstepB;
    const unsigned ldsw = (unsigned)wid * 1024u;
    const int aoff = lds_byte(wr * 64 + fr, fq * 8), boff = lds_byte(wc * 32 + fr, fq * 8);
#define PG8_SA(b, h) (((b) * 2 + (h)) * HTB)
#define PG8_SB(b, h) ((4 + (b) * 2 + (h)) * HTB)
#define PG8_STAGE(bufoff, gbase, voff) do { _Pragma("unroll") for (int _i = 0; _i < 2; ++_i) \
        __builtin_amdgcn_global_load_lds((const unsigned*)((const char*)(gbase) + (voff)[_i]), (PG8_LAS unsigned*)(lds + (bufoff) + ldsw + _i * 8192), 16, 0, 0); } while (0)
#define PG8_LDA(dst, b, h) do { _Pragma("unroll") for (int m = 0; m < 4; ++m) _Pragma("unroll") for (int k = 0; k < 2; ++k) dst[m][k] = *(const PG8_LAS bf16x8*)(lds + PG8_SA(b, h) + aoff + m * 2048 + k * 1024); } while (0)
#define PG8_LDB(dst, b, h) do { _Pragma("unroll") for (int n = 0; n < 2; ++n) _Pragma("unroll") for (int k = 0; k < 2; ++k) dst[n][k] = *(const PG8_LAS bf16x8*)(lds + PG8_SB(b, h) + boff + n * 2048 + k * 1024); } while (0)
#define PG8_MMA(ai, bj, At, Bt) do { __builtin_amdgcn_s_setprio(1); _Pragma("unroll") for (int m = 0; m < 4; ++m) _Pragma("unroll") for (int n = 0; n < 2; ++n) _Pragma("unroll") for (int k = 0; k < 2; ++k) \
        acc[ai][bj][m][n] = __builtin_amdgcn_mfma_f32_16x16x32_bf16(Bt[n][k], At[m][k], acc[ai][bj][m][n], 0, 0, 0); __builtin_amdgcn_s_setprio(0); } while (0)
#define PG8_WAIT_V(n) asm volatile("s_waitcnt vmcnt(" #n ")" ::: "memory")
#define PG8_WAIT_L(n) asm volatile("s_waitcnt lgkmcnt(" #n ")" ::: "memory")
#define PG8_BAR __builtin_amdgcn_s_barrier()
#define PG8_SCHED __builtin_amdgcn_sched_barrier(0)
    Unit cur, nxt; int ui = 0;
    if (!S.next(0, cur)) return;
    f32x4 acc[2][2][4][2];
#pragma unroll
    for (int a = 0; a < 2; ++a)
#pragma unroll
        for (int b = 0; b < 2; ++b)
#pragma unroll
            for (int m = 0; m < 4; ++m)
#pragma unroll
                for (int n = 0; n < 2; ++n) acc[a][b][m][n] = (f32x4){0.f, 0.f, 0.f, 0.f};
    bf16x8 At[4][2], B0[2][2], B1[2][2];
    const char* cA = (const char*)g.A + (size_t)cur.pm * tstepA + cur.ko; const char* cB = (const char*)g.Bt + (size_t)cur.pn * tstepB + cur.ko;
    S.a_ready(cur);
    if constexpr (SP2) {
        PG8_STAGE(PG8_SB(0, 0), cB, voffB); PG8_STAGE(PG8_SB(0, 1), cB + hstepB, voffB); PG8_STAGE(PG8_SA(0, 0), cA, voffA); PG8_STAGE(PG8_SA(0, 1), cA + hstepA, voffA);
        if (wr == 1) PG8_BAR;
        PG8_WAIT_V(2); PG8_BAR;
        PG8_STAGE(PG8_SB(1, 0), cB + kstep, voffB); PG8_STAGE(PG8_SA(1, 0), cA + kstep, voffA); PG8_STAGE(PG8_SB(1, 1), cB + hstepB + kstep, voffB);
        PG8_WAIT_V(6); PG8_BAR;
    } else {
        PG8_STAGE(PG8_SB(0, 0), cB, voffB); PG8_STAGE(PG8_SA(0, 0), cA, voffA); PG8_STAGE(PG8_SB(0, 1), cB + hstepB, voffB); PG8_STAGE(PG8_SA(0, 1), cA + hstepA, voffA);
        if (wr == 1) PG8_BAR;
        PG8_WAIT_V(4); PG8_BAR;
        PG8_STAGE(PG8_SB(1, 0), cB + kstep, voffB); PG8_STAGE(PG8_SA(1, 0), cA + kstep, voffA); PG8_STAGE(PG8_SB(1, 1), cB + hstepB + kstep, voffB);
        PG8_WAIT_V(6); PG8_BAR;
    }
    for (;;) {
        const bool has_next = S.next(ui + 1, nxt);
        const char* nA = has_next ? (const char*)g.A + (size_t)nxt.pm * tstepA + nxt.ko : cA; const char* nB = has_next ? (const char*)g.Bt + (size_t)nxt.pn * tstepB + nxt.ko : cB;
        for (int t = 0; t < nt; t += 2) {
            const bool last = (t == nt - 2);
            const char* a1 = cA + (size_t)(t + 1) * kstep;
            const char* a2 = last ? nA : cA + (size_t)(t + 2) * kstep; const char* b2 = last ? nB : cB + (size_t)(t + 2) * kstep;
            const char* a3 = a2 + kstep; const char* b3 = b2 + kstep;
            if (last && has_next) S.a_ready(nxt);
            if constexpr (SP2) {
            PG8_LDB(B0, 0, 0); PG8_LDB(B1, 0, 1); PG8_SCHED; PG8_LDA(At, 0, 0); PG8_STAGE(PG8_SA(1, 1), a1 + hstepA, voffA);
            PG8_WAIT_V(8); PG8_WAIT_L(0); PG8_BAR; PG8_MMA(0, 0, At, B0); PG8_MMA(0, 1, At, B1); PG8_BAR; PG8_SCHED;
            PG8_LDA(At, 0, 1); PG8_STAGE(PG8_SB(0, 0), b2, voffB); PG8_STAGE(PG8_SB(0, 1), b2 + hstepB, voffB); PG8_STAGE(PG8_SA(0, 0), a2, voffA);
            PG8_WAIT_V(8); PG8_WAIT_L(0); PG8_BAR; PG8_MMA(1, 0, At, B0); PG8_MMA(1, 1, At, B1); PG8_BAR; PG8_SCHED;
            PG8_LDB(B0, 1, 0); PG8_LDB(B1, 1, 1); PG8_SCHED; PG8_LDA(At, 1, 0); PG8_STAGE(PG8_SA(0, 1), a2 + hstepA, voffA);
            PG8_WAIT_V(8); PG8_WAIT_L(0); PG8_BAR; PG8_MMA(0, 0, At, B0); PG8_MMA(0, 1, At, B1); PG8_BAR; PG8_SCHED;
            PG8_LDA(At, 1, 1); PG8_STAGE(PG8_SB(1, 0), b3, voffB); PG8_STAGE(PG8_SB(1, 1), b3 + hstepB, voffB); PG8_STAGE(PG8_SA(1, 0), a3, voffA);
            PG8_WAIT_V(8); PG8_WAIT_L(0); PG8_BAR; PG8_MMA(1, 0, At, B0); PG8_MMA(1, 1, At, B1); PG8_BAR; PG8_SCHED;
            } else {
            PG8_LDB(B0, 0, 0); PG8_SCHED; PG8_LDA(At, 0, 0); PG8_STAGE(PG8_SA(1, 1), a1 + hstepA, voffA);
            PG8_WAIT_L(8); PG8_BAR; PG8_WAIT_L(0); PG8_MMA(0, 0, At, B0); PG8_BAR; PG8_SCHED;
            PG8_LDB(B1, 0, 1); PG8_STAGE(PG8_SB(0, 0), b2, voffB);
            PG8_BAR; PG8_WAIT_L(0); PG8_MMA(0, 1, At, B1); PG8_BAR;
            PG8_LDA(At, 0, 1); PG8_STAGE(PG8_SA(0, 0), a2, voffA);
            PG8_BAR; PG8_WAIT_L(0); PG8_MMA(1, 0, At, B0); PG8_BAR; PG8_SCHED;
            PG8_STAGE(PG8_SB(0, 1), b2 + hstepB, voffB);
            PG8_WAIT_V(6); PG8_BAR; PG8_MMA(1, 1, At, B1); PG8_BAR;
            PG8_LDB(B0, 1, 0); PG8_SCHED; PG8_LDA(At, 1, 0); PG8_STAGE(PG8_SA(0, 1), a2 + hstepA, voffA);
            PG8_WAIT_L(8); PG8_BAR; PG8_WAIT_L(0); PG8_MMA(0, 0, At, B0); PG8_BAR; PG8_SCHED;
            PG8_LDB(B1, 1, 1); PG8_STAGE(PG8_SB(1, 0), b3, voffB);
            PG8_BAR; PG8_WAIT_L(0); PG8_MMA(0, 1, At, B1); PG8_BAR;
            PG8_LDA(At, 1, 1); PG8_STAGE(PG8_SA(1, 0), a3, voffA);
            PG8_BAR; PG8_WAIT_L(0); PG8_MMA(1, 0, At, B0); PG8_BAR; PG8_SCHED;
            PG8_STAGE(PG8_SB(1, 1), b3 + hstepB, voffB);
            PG8_WAIT_V(6); PG8_BAR; PG8_MMA(1, 1, At, B1); PG8_BAR;
            }
        }
        if constexpr (ALIGN_EPI) { if (wr == 0) PG8_BAR; }
        if constexpr (!Epi::AFTER_DRAIN) { E(acc, cur, wr, wc, fr, fq, lds); S.done(cur); }
        if (!has_next) break;
        if (!(Epi::CHAIN && cur.ko == 0))
#pragma unroll
        for (int a = 0; a < 2; ++a)
#pragma unroll
            for (int b = 0; b < 2; ++b)
#pragma unroll
                for (int m = 0; m < 4; ++m)
#pragma unroll
                    for (int n = 0; n < 2; ++n) acc[a][b][m][n] = (f32x4){0.f, 0.f, 0.f, 0.f};
        cur = nxt; cA = nA; cB = nB; ++ui;
        if constexpr (ALIGN_EPI) { if (wr == 1) PG8_BAR; }
    }
    PG8_WAIT_V(0);
    if constexpr (!ALIGN_EPI) { if (wr == 0) PG8_BAR; }
    PG8_BAR;
    if constexpr (Epi::AFTER_DRAIN) { E.fused(acc, cur, wr, wc, fr, fq, lds, wid, lane); S.done(cur); }
#undef PG8_SA
#undef PG8_SB
#undef PG8_STAGE
#undef PG8_LDA
#undef PG8_LDB
#undef PG8_MMA
#undef PG8_WAIT_V
#undef PG8_WAIT_L
#undef PG8_BAR
#undef PG8_SCHED
}
}
#include <hip/hip_bf16.h>
#include <cmath>
namespace attn_body {
using bf16=__hip_bfloat16;
using bf16x8=__attribute__((ext_vector_type(8)))short;
using s16x4=__attribute__((ext_vector_type(4)))short;
using f32x16=__attribute__((ext_vector_type(16)))float;
using u32x4=__attribute__((ext_vector_type(4)))unsigned;
constexpr int D=64,QP=512,KP=256,OP=1024;
constexpr int NW=8,QBLK=32,QB=QBLK*NW,KVBLK=64;
__device__ __forceinline__ int crow(int r,int hi){return (r&3)+8*(r>>2)+4*hi;}
#define SBAR() __builtin_amdgcn_sched_barrier(0)
__device__ __forceinline__ void cmask(f32x16&p0,f32x16&p1,int jb,int qrel,int hi){
  const float NEG=-INFINITY; int kb=64*jb+4*hi;
  #pragma unroll
  for(int r=0;r<16;++r){int kv=kb+(r&3)+8*(r>>2); if(kv>qrel)p0[r]=NEG; if(kv+32>qrel)p1[r]=NEG;}
}

constexpr int NSLOT=3, SLOTB=8192;
constexpr int LDS_K=0, LDS_V=NSLOT*SLOTB, LDS_WS=2*NSLOT*SLOTB, LDS_OST=LDS_WS+NW*64*4, LDS_BYTES=LDS_OST+NW*4096;
constexpr float C2=0.125f*1.4426950408889634f;
__device__ __forceinline__ void glds16(const void*gsrc,unsigned lds_dst){unsigned keep;
  asm volatile("s_mov_b32 %0, m0\n\ts_mov_b32 m0, %2\n\ts_nop 0\n\tglobal_load_lds_dwordx4 %1, off\n\ts_mov_b32 m0, %0":"=&s"(keep):"v"(gsrc),"s"(lds_dst):"memory");}
__device__ __forceinline__ float max3f(float a,float b,float c){float r;asm("v_max3_f32 %0, %1, %2, %3":"=v"(r):"v"(a),"v"(b),"v"(c));return r;}
__device__ __forceinline__ float max2f(float a,float b){float r;asm("v_max_f32_e32 %0, %1, %2":"=v"(r):"v"(a),"v"(b));return r;}
__device__ __forceinline__ float fadd_s(float a,float b){float r;asm("v_add_f32_e32 %0, %1, %2":"=v"(r):"v"(a),"v"(b));return r;}
__device__ __forceinline__ float fsub_s(float a,float b){float r;asm("v_sub_f32_e32 %0, %1, %2":"=v"(r):"v"(a),"v"(b));return r;}
typedef float f32x2_t __attribute__((ext_vector_type(2))); typedef __bf16 bf16x2_t __attribute__((ext_vector_type(2)));
__device__ __forceinline__ unsigned cvtpk_s(float lo,float hi){f32x2_t v={lo,hi};bf16x2_t b=__builtin_convertvector(v,bf16x2_t);return __builtin_bit_cast(unsigned,b);}
#define WAIT_BAR(N) asm volatile("s_waitcnt vmcnt(" #N ") lgkmcnt(0)\n\ts_barrier":::"memory")

__device__ __forceinline__ void qkt(f32x16&p0,f32x16&p1,const char*Kslot,const bf16x8*qr,const f32x16&negm,int r32,int hi){
  const char*kb=Kslot+hi*1024+r32*16;
  #pragma unroll
  for(int d0=0;d0<4;++d0){
    const bf16x8 b0=*reinterpret_cast<const bf16x8*>(kb+d0*2048);
    const bf16x8 b1=*reinterpret_cast<const bf16x8*>(kb+d0*2048+512);
    if(d0==0){p0=__builtin_amdgcn_mfma_f32_32x32x16_bf16(b0,qr[0],negm,0,0,0);p1=__builtin_amdgcn_mfma_f32_32x32x16_bf16(b1,qr[0],negm,0,0,0);}
    else{p0=__builtin_amdgcn_mfma_f32_32x32x16_bf16(b0,qr[d0],p0,0,0,0);p1=__builtin_amdgcn_mfma_f32_32x32x16_bf16(b1,qr[d0],p1,0,0,0);}}
}
typedef __attribute__((address_space(3))) const char* lds_cptr;
typedef short v4i16_t __attribute__((ext_vector_type(4)));
__device__ __forceinline__ void kload8(bf16x8*kf,lds_cptr kp){
  kf[0]=*(const __attribute__((address_space(3))) bf16x8*)(kp);      kf[1]=*(const __attribute__((address_space(3))) bf16x8*)(kp+512);
  kf[2]=*(const __attribute__((address_space(3))) bf16x8*)(kp+2048); kf[3]=*(const __attribute__((address_space(3))) bf16x8*)(kp+2560);
  kf[4]=*(const __attribute__((address_space(3))) bf16x8*)(kp+4096); kf[5]=*(const __attribute__((address_space(3))) bf16x8*)(kp+4608);
  kf[6]=*(const __attribute__((address_space(3))) bf16x8*)(kp+6144); kf[7]=*(const __attribute__((address_space(3))) bf16x8*)(kp+6656);
}
__device__ __forceinline__ void kload2(bf16x8*kf,lds_cptr kp,int j){ kf[2*j]=*(const __attribute__((address_space(3))) bf16x8*)(kp+j*2048); kf[2*j+1]=*(const __attribute__((address_space(3))) bf16x8*)(kp+j*2048+512); }
__device__ __forceinline__ s16x4 vtr(lds_cptr p){ return __builtin_bit_cast(s16x4,__builtin_amdgcn_ds_read_tr16_b64_v4i16((__attribute__((address_space(3))) v4i16_t*)p)); }
__device__ __forceinline__ float rowmax(const f32x16&p0,const f32x16&p1){
  float a=max3f(p0[0],p0[1],p1[0]),b=max3f(p0[2],p0[3],p1[1]);a=max3f(a,p1[2],p1[3]);
  #pragma unroll
  for(int r=4;r<16;r+=4){a=max3f(a,p0[r],p0[r+1]);b=max3f(b,p0[r+2],p0[r+3]);a=max3f(a,p1[r],p1[r+1]);b=max3f(b,p1[r+2],p1[r+3]);}
  const float m=max2f(a,b);
  auto rr=__builtin_amdgcn_permlane32_swap(__float_as_uint(m),__float_as_uint(m),false,false);
  return max2f(__uint_as_float(rr[0]),__uint_as_float(rr[1]));
}
__device__ __forceinline__ void pv(f32x16*o,int vb,bf16x8 pa0,bf16x8 pa1,bf16x8 pa2,bf16x8 pa3){
  #pragma unroll
  for(int d0=0;d0<2;++d0){s16x4 lo[4],hi[4];
    #pragma unroll
    for(int ks=0;ks<4;++ks){
      asm volatile("ds_read_b64_tr_b16 %0,%1 offset:%c2":"=&v"(lo[ks]):"v"(vb),"i"(d0*4096+ks*1024):"memory");
      asm volatile("ds_read_b64_tr_b16 %0,%1 offset:%c2":"=&v"(hi[ks]):"v"(vb),"i"(d0*4096+ks*1024+512):"memory");}
    asm volatile("s_waitcnt lgkmcnt(0)":::"memory");SBAR();
    #define PK(k) (bf16x8){lo[k][0],lo[k][1],lo[k][2],lo[k][3],hi[k][0],hi[k][1],hi[k][2],hi[k][3]}
    o[d0]=__builtin_amdgcn_mfma_f32_32x32x16_bf16(pa0,PK(0),o[d0],0,0,0);
    o[d0]=__builtin_amdgcn_mfma_f32_32x32x16_bf16(pa1,PK(1),o[d0],0,0,0);
    o[d0]=__builtin_amdgcn_mfma_f32_32x32x16_bf16(pa2,PK(2),o[d0],0,0,0);
    o[d0]=__builtin_amdgcn_mfma_f32_32x32x16_bf16(pa3,PK(3),o[d0],0,0,0);
    #undef PK
  }
}

#ifndef ATTN_STORE16
#define ATTN_STORE16(p,v) (*(u32x4*)(p)=(v))
#endif
template<int THRL> __device__ __forceinline__ void attn_unit(long rowbase,int NT,int h,int q0,const bf16*Q,const bf16*__restrict__ K,const bf16*__restrict__ V,bf16*O,char*shm){
  const int tid=threadIdx.x,lane=tid&63,r32=lane&31,hi=lane>>5; const int wid=__builtin_amdgcn_readfirstlane(tid>>6);
  const bf16*Qw=Q+(rowbase+q0+wid*QBLK)*QP+h*D;
  const bf16*Kh=K+rowbase*KP+(h>>2)*D,*Vh=V+rowbase*KP+(h>>2)*D;
  const unsigned lds0=(unsigned)(uintptr_t)shm;
  float*wsf=(float*)(shm+LDS_WS)+wid*64;
  const bf16*ksrc=Kh+(long)lane*KP+wid*8;
  const bf16*vsrc=Vh+(long)(16*(wid&3)+(lane>>2))*KP+(wid>>2)*32+(lane&3)*8;
  const unsigned kdst=lds0+LDS_K+wid*1024, vdst=lds0+LDS_V+wid*1024;
  #define DMA_K(t,slot) glds16(ksrc+(long)(t)*KVBLK*KP,(unsigned)__builtin_amdgcn_readfirstlane(kdst+(slot)))
  #define DMA_V(t,slot) glds16(vsrc+(long)(t)*KVBLK*KP,(unsigned)__builtin_amdgcn_readfirstlane(vdst+(slot)))
  const int vb0=(int)(lds0+LDS_V)+((lane>>4)&1)*32+(lane&3)*8+(4*hi+((lane&15)>>2))*64;
  const char*Kbase=shm+LDS_K; bf16x8 kf[8];
  const lds_cptr shm3=(lds_cptr)shm; const lds_cptr kp0=shm3+LDS_K+hi*1024+r32*16; const lds_cptr vp0=shm3+LDS_V+((lane>>4)&1)*32+(lane&3)*8+(4*hi+((lane&15)>>2))*64;
  DMA_K(0,0);DMA_V(0,0);DMA_K(1,SLOTB);
  bf16x8 qr[4];
  #pragma unroll
  for(int d0=0;d0<4;++d0)qr[d0]=*reinterpret_cast<const bf16x8*>(&Qw[(long)r32*QP+d0*16+hi*8]);
  float mhat=0.f,l_reg=0.f;f32x16 o[2];o[0]=f32x16{};o[1]=f32x16{};f32x16 negm=f32x16{};asm volatile("":"+v"(negm));
  #define CMASK(P0,P1,t) do{}while(0)
  bool resc=false;
  #define START(P0,P1) do{ const float rm=rowmax(P0,P1); resc=false; \
    { const float dl=rm; mhat=fadd_s(mhat,dl); \
      _Pragma("unroll") for(int r=0;r<16;++r){P0[r]=fsub_s(P0[r],dl);P1[r]=fsub_s(P1[r],dl);} \
      _Pragma("unroll") for(int r=0;r<16;++r)negm[r]=-mhat; asm volatile("":"+v"(negm)); } \
    _Pragma("unroll") for(int r=0;r<16;++r)P0[r]=__builtin_amdgcn_exp2f(P0[r]); }while(0)
  #define RESC() do{ if(resc){ asm volatile("s_waitcnt lgkmcnt(0)":::"memory"); \
      _Pragma("unroll") for(int d_=0;d_<2;++d_) _Pragma("unroll") for(int r=0;r<16;++r)o[d_][r]*=wsf[crow(r,hi)]; } }while(0)
  f32x16 pA0,pA1,pB0,pB1;
  int sl_prev=0,sl_cur=0,sl_next=SLOTB;
  #define ROT() do{sl_prev=sl_cur;sl_cur=sl_next;sl_next=(sl_next==(NSLOT-1)*SLOTB)?0:sl_next+SLOTB;}while(0)
  DMA_K(2,2*SLOTB);
  WAIT_BAR(3);
  qkt(pA0,pA1,Kbase,qr,negm,r32,hi);asm volatile("s_nop 15\n\ts_nop 7":"+v"(pA0),"+v"(pA1));CMASK(pA0,pA1,0);
  START(pA0,pA1);
  _Pragma("unroll") for(int r=0;r<16;++r)pA1[r]=__builtin_amdgcn_exp2f(pA1[r]);
  WAIT_BAR(0);
  DMA_K(3,0);DMA_V(1,SLOTB);
  ROT();
  kload8(kf,kp0+sl_cur);
  WAIT_BAR(2);
  s16x4 vlo[8],vhi[8]; u32x4 pw0,pw1,pw2,pw3;
  #define PKW(P,B) cvtpk_s(P[B],P[B+1])
  #define PAF(k) __builtin_bit_cast(bf16x8,pw##k)
  #define VFR(i) (bf16x8){vlo[i][0],vlo[i][1],vlo[i][2],vlo[i][3],vhi[i][0],vhi[i][1],vhi[i][2],vhi[i][3]}
  #define PIN(x) asm volatile("":"+v"(x))
  #define MX3(a,b,c) __builtin_fmaxf(__builtin_fmaxf((a),(b)),(c))
  #define GAPA(MF,A0,A1,A2,A3,W0,W1,PW) do{ MF; sacc+=A0; sacc+=A1; sacc+=A2; sacc+=A3; PIN(sacc); W0; W1; PIN(PW); SBAR(); }while(0)
  #define EX(v) __builtin_amdgcn_exp2f(v)
  #define GAPB(MF,X,B) do{ MF; X[B]=EX(X[B]); X[B+1]=EX(X[B+1]); X[B+2]=EX(X[B+2]); X[B+3]=EX(X[B+3]); PIN(X); SBAR(); }while(0)
  #define VRD(i) do{ vlo[i]=vtr(vp_+(((i)>>2)*4096+((i)&3)*1024)); vhi[i]=vtr(vp_+(((i)>>2)*4096+((i)&3)*1024+512)); }while(0)
  #define KRD(G,j) do{ if(G){ kload2(kf,kp0+sl_next,j); SBAR(); } }while(0)
  #define STEP(C0,C1,P0,P1,t,GK,GV,GL) do{ SBAR(); \
    const lds_cptr vp_=vp0+sl_prev; \
    VRD(0); SBAR(); float sacc=(P0[0]+P0[1]); \
    GAPA(C0=__builtin_amdgcn_mfma_f32_32x32x16_bf16(kf[0],qr[0],negm,0,0,0), P0[2],P0[3],P0[4],P0[5],     pw0[0]=PKW(P0,0), pw0[1]=PKW(P0,2), pw0); \
    VRD(4); SBAR(); GAPA(C1=__builtin_amdgcn_mfma_f32_32x32x16_bf16(kf[1],qr[0],negm,0,0,0), P0[6],P0[7],P0[8],P0[9],     pw0[2]=PKW(P0,4), pw0[3]=PKW(P0,6), pw0); \
    VRD(1); SBAR(); GAPA(C0=__builtin_amdgcn_mfma_f32_32x32x16_bf16(kf[2],qr[1],C0,0,0,0),   P0[10],P0[11],P0[12],P0[13], pw1[0]=PKW(P0,8), pw1[1]=PKW(P0,10), pw1); \
    VRD(5); SBAR(); GAPA(C1=__builtin_amdgcn_mfma_f32_32x32x16_bf16(kf[3],qr[1],C1,0,0,0),   P0[14],P0[15],P1[0],P1[1],   pw1[2]=PKW(P0,12),pw1[3]=PKW(P0,14), pw1); \
    VRD(2); SBAR(); GAPA(C0=__builtin_amdgcn_mfma_f32_32x32x16_bf16(kf[4],qr[2],C0,0,0,0),   P1[2],P1[3],P1[4],P1[5],     pw2[0]=PKW(P1,0), pw2[1]=PKW(P1,2), pw2); \
    VRD(6); SBAR(); GAPA(C1=__builtin_amdgcn_mfma_f32_32x32x16_bf16(kf[5],qr[2],C1,0,0,0),   P1[6],P1[7],P1[8],P1[9],     pw2[2]=PKW(P1,4), pw2[3]=PKW(P1,6), pw2); \
    VRD(3); SBAR(); GAPA(C0=__builtin_amdgcn_mfma_f32_32x32x16_bf16(kf[6],qr[3],C0,0,0,0),   P1[10],P1[11],P1[12],P1[13], pw3[0]=PKW(P1,8), pw3[1]=PKW(P1,10), pw3); \
    VRD(7); SBAR(); GAPA(C1=__builtin_amdgcn_mfma_f32_32x32x16_bf16(kf[7],qr[3],C1,0,0,0),   P1[14],P1[15],0.f,0.f,       pw3[2]=PKW(P1,12),pw3[3]=PKW(P1,14), pw3); \
    l_reg+=sacc; \
    if(GK){DMA_K((t)+3,sl_cur);} if(GV){DMA_V((t)+1,sl_next);} \
    CMASK(C0,C1,t); \
    { float a=MX3(C0[0],C0[1],C1[0]),b=MX3(C0[2],C0[3],C1[1]); a=MX3(a,C1[2],C1[3]); \
      _Pragma("unroll") for(int r=4;r<16;r+=4){a=MX3(a,C0[r],C0[r+1]);b=MX3(b,C0[r+2],C0[r+3]);a=MX3(a,C1[r],C1[r+1]);b=MX3(b,C1[r+2],C1[r+3]);} \
      float rm=__builtin_fmaxf(a,b); { auto rr=__builtin_amdgcn_permlane32_swap(__float_as_uint(rm),__float_as_uint(rm),false,false); rm=__builtin_fmaxf(__uint_as_float(rr[0]),__uint_as_float(rr[1])); } \
      resc=false; \
      if(__builtin_expect(__any(rm>(float)THRL),0)){ const float dl=__builtin_fmaxf(rm,0.f); mhat+=dl; \
        _Pragma("unroll") for(int r=0;r<16;++r){C0[r]-=dl;C1[r]-=dl;} \
        _Pragma("unroll") for(int r=0;r<16;++r)negm[r]=-mhat; asm volatile("":"+v"(negm)); \
        const float f=__builtin_amdgcn_exp2f(-dl); l_reg*=f; if(hi==0)wsf[r32]=f; resc=true; } } \
    SBAR(); \
    GAPB(o[0]=__builtin_amdgcn_mfma_f32_32x32x16_bf16(PAF(0),VFR(0),o[0],0,0,0), C0,0); \
    GAPB(o[1]=__builtin_amdgcn_mfma_f32_32x32x16_bf16(PAF(0),VFR(4),o[1],0,0,0), C0,4); \
    KRD(GL,0); GAPB(o[0]=__builtin_amdgcn_mfma_f32_32x32x16_bf16(PAF(1),VFR(1),o[0],0,0,0), C0,8); \
    KRD(GL,1); GAPB(o[1]=__builtin_amdgcn_mfma_f32_32x32x16_bf16(PAF(1),VFR(5),o[1],0,0,0), C0,12); \
    KRD(GL,2); GAPB(o[0]=__builtin_amdgcn_mfma_f32_32x32x16_bf16(PAF(2),VFR(2),o[0],0,0,0), C1,0); \
    KRD(GL,3); GAPB(o[1]=__builtin_amdgcn_mfma_f32_32x32x16_bf16(PAF(2),VFR(6),o[1],0,0,0), C1,4); \
    GAPB(o[0]=__builtin_amdgcn_mfma_f32_32x32x16_bf16(PAF(3),VFR(3),o[0],0,0,0), C1,8); \
    GAPB(o[1]=__builtin_amdgcn_mfma_f32_32x32x16_bf16(PAF(3),VFR(7),o[1],0,0,0), C1,12); \
    }while(0)
  int t=1;
  #undef CMASK
  #define CMASK(P0,P1,t) do{}while(0)
  for(;t+5<NT;t+=2){
    STEP(pB0,pB1,pA0,pA1,t,true,true,true);     WAIT_BAR(2); RESC(); ROT();
    STEP(pA0,pA1,pB0,pB1,t+1,true,true,true);   WAIT_BAR(2); RESC(); ROT();
  }
  #undef CMASK
  #define CMASK(P0,P1,t) do{}while(0)
  #define ENDW(tt) do{ if((tt)+3<NT){WAIT_BAR(2);} else if((tt)+2<NT){WAIT_BAR(1);} else {WAIT_BAR(0);} }while(0)
  for(;t+1<NT;t+=2){
    STEP(pB0,pB1,pA0,pA1,t,(t+3<NT),(t+1<NT),(t+1<NT));       ENDW(t);   RESC(); ROT();
    STEP(pA0,pA1,pB0,pB1,t+1,(t+4<NT),(t+2<NT),(t+2<NT));     ENDW(t+1); RESC(); ROT();
  }
  STEP(pB0,pB1,pA0,pA1,NT-1,false,false,false); RESC();
  { float sacc=pB0[0]+pB0[1]; _Pragma("unroll") for(int r=2;r<16;++r)sacc+=pB0[r]; _Pragma("unroll") for(int r=0;r<16;++r)sacc+=pB1[r]; l_reg+=sacc;
    pw0=(u32x4){PKW(pB0,0),PKW(pB0,2),PKW(pB0,4),PKW(pB0,6)};pw1=(u32x4){PKW(pB0,8),PKW(pB0,10),PKW(pB0,12),PKW(pB0,14)};pw2=(u32x4){PKW(pB1,0),PKW(pB1,2),PKW(pB1,4),PKW(pB1,6)};pw3=(u32x4){PKW(pB1,8),PKW(pB1,10),PKW(pB1,12),PKW(pB1,14)};
    SBAR(); pv(o,vb0+sl_cur,PAF(0),PAF(1),PAF(2),PAF(3)); }
  #undef PKW
  #undef PAF
  #undef VFR
  #undef PIN
  #undef MX3
  #undef GAPA
  #undef GAPB
  #undef EX
  #undef VRD
  #undef KRD
  #undef STEP
  #undef ENDW
  {auto rr=__builtin_amdgcn_permlane32_swap(__float_as_uint(l_reg),__float_as_uint(l_reg),false,false);l_reg=__uint_as_float(rr[0])+__uint_as_float(rr[1]);}
  if(hi==0)wsf[32+r32]=l_reg;asm volatile("s_waitcnt lgkmcnt(0)":::"memory");
  float rli[16];
  #pragma unroll
  for(int r=0;r<16;++r)rli[r]=__builtin_amdgcn_rcpf(wsf[32+crow(r,hi)]);
  bf16*Ow=O+(rowbase+q0+wid*QBLK)*OP+h*D;
  { bf16*stg=(bf16*)(shm+LDS_OST)+wid*2048;
    #pragma unroll
    for(int r=0;r<16;++r){const int orow=crow(r,hi);
      #pragma unroll
      for(int d0=0;d0<2;++d0)stg[orow*64+d0*32+r32]=__float2bfloat16(o[d0][r]*rli[r]);}
    asm volatile("s_waitcnt lgkmcnt(0)":::"memory");
    #pragma unroll
    for(int i=0;i<4;++i){const int row=i*8+(lane>>3),ch=lane&7; const u32x4 v=*(const u32x4*)(stg+row*64+ch*8); ATTN_STORE16(Ow+(long)row*OP+ch*8,v);} }
  asm volatile("s_waitcnt lgkmcnt(0)\n\ts_barrier":::"memory");
  #undef DMA_K
  #undef DMA_V
  #undef CMASK
  #undef START
  #undef RESC
  #undef ROT
}
constexpr int ATTN_LDS_BYTES=LDS_BYTES;
#undef SBAR
#undef WAIT_BAR
}
namespace nat {
#define NLAS __attribute__((address_space(3)))
typedef short bf16x8 __attribute__((ext_vector_type(8)));
typedef short s16x4 __attribute__((ext_vector_type(4)));
typedef float f32x4 __attribute__((ext_vector_type(4)));
typedef unsigned u32x4 __attribute__((ext_vector_type(4)));
typedef unsigned u32x2 __attribute__((ext_vector_type(2)));
typedef unsigned short bf16_t;
constexpr int VOFF = 73728, RPB_OFF = 147456;
__device__ __forceinline__ s16x4 vtr(const NLAS unsigned char* p) { return __builtin_bit_cast(s16x4, __builtin_amdgcn_ds_read_tr16_b64_v4i16((NLAS s16x4*)p)); }
__device__ __forceinline__ unsigned cvtpk(float lo, float hi) { unsigned r; asm volatile("v_cvt_pk_bf16_f32 %0, %1, %2" : "=v"(r) : "v"(lo), "v"(hi)); return r; }
__device__ __forceinline__ int swz(int key, int chunk) { return key * 128 + ((chunk ^ ((key >> 1) & 7)) << 4); }
__device__ __forceinline__ int clampi(int v, int lo, int hi) { return v < lo ? lo : (v > hi ? hi : v); }

__device__ __forceinline__ void step(const bf16x8 bq0, const bf16x8 bq1, bf16_t* __restrict__ OAB, const NLAS float* rp, const NLAS unsigned char* L, long row0, int ra, int rsa, int rsb, int lo, int nb, int h, int wave, int lane) {
    const int n = lane & 15, g = lane >> 4, qc = 8 * wave + (n & 7);
    const int kc0 = clampi(8 * wave - 8, 0, 32);
    const int myr = ra + (n >> 3), myrs = (n < 8) ? rsa : rsb;
    const int cs = clampi(qc - 8, 0, 48);
    int ci[2][4];
#pragma unroll
    for (int kt = 0; kt < 2; ++kt)
#pragma unroll
        for (int i = 0; i < 4; ++i) { const int kc = kc0 + 16 * kt + 4 * g + i; ci[kt][i] = (kc >= cs && kc < cs + 16) ? clampi(kc - qc + 15, 0, 30) : 31; }
    f32x4 s[9][2];
#pragma unroll
    for (int bi = 0; bi < 9; ++bi) {
        if (bi < 8 || nb == 9) { const int br = lo + bi; const NLAS unsigned char* ks = L + (br % 9) * 8192;
            const bool inw = (br >= myrs) && (br <= myrs + 7); const int rofs = inw ? (br - myr + 7) * 32 : 15 * 32;
#pragma unroll
            for (int kt = 0; kt < 2; ++kt) { const int key = kc0 + 16 * kt + n;
                const bf16x8 a0 = *(const NLAS bf16x8*)(ks + swz(key, g)), a1 = *(const NLAS bf16x8*)(ks + swz(key, 4 + g));
                f32x4 c;
#pragma unroll
                for (int i = 0; i < 4; ++i) c[i] = rp[rofs + ci[kt][i]];
                c = __builtin_amdgcn_mfma_f32_16x16x32_bf16(a0, bq0, c, 0, 0, 0); c = __builtin_amdgcn_mfma_f32_16x16x32_bf16(a1, bq1, c, 0, 0, 0);
                s[bi][kt] = c; }
        } else { s[bi][0] = (f32x4){-INFINITY, -INFINITY, -INFINITY, -INFINITY}; s[bi][1] = s[bi][0]; }
    }
    float mx = -INFINITY;
#pragma unroll
    for (int bi = 0; bi < 9; ++bi)
#pragma unroll
        for (int kt = 0; kt < 2; ++kt)
#pragma unroll
            for (int i = 0; i < 4; ++i) mx = fmaxf(mx, s[bi][kt][i]);
    mx = fmaxf(mx, __shfl_xor(mx, 16)); mx = fmaxf(mx, __shfl_xor(mx, 32));
    float sum = 0.f;
#pragma unroll
    for (int bi = 0; bi < 9; ++bi)
#pragma unroll
        for (int kt = 0; kt < 2; ++kt)
#pragma unroll
            for (int i = 0; i < 4; ++i) { const float p = __builtin_amdgcn_exp2f(s[bi][kt][i] - mx); s[bi][kt][i] = p; sum += p; }
    sum += __shfl_xor(sum, 16); sum += __shfl_xor(sum, 32);
    const float inv = 1.0f / sum;
    f32x4 o[4];
#pragma unroll
    for (int dt = 0; dt < 4; ++dt) o[dt] = (f32x4){0.f, 0.f, 0.f, 0.f};
    const int qq = (lane & 15) >> 2, pp = lane & 3;
#pragma unroll
    for (int bi = 0; bi < 9; ++bi) {
        if (bi < 8 || nb == 9) { const NLAS unsigned char* vs = L + VOFF + ((lo + bi) % 9) * 8192;
            u32x4 pw; pw.x = cvtpk(s[bi][0][0], s[bi][0][1]); pw.y = cvtpk(s[bi][0][2], s[bi][0][3]); pw.z = cvtpk(s[bi][1][0], s[bi][1][1]); pw.w = cvtpk(s[bi][1][2], s[bi][1][3]);
            const bf16x8 pb = __builtin_bit_cast(bf16x8, pw);
            const int k0 = kc0 + 4 * g + qq, k1 = k0 + 16;
            s16x4 vlo[4], vhi[4];
#pragma unroll
            for (int dt = 0; dt < 4; ++dt) { vlo[dt] = vtr(vs + swz(k0, 2 * dt + (pp >> 1)) + 8 * (pp & 1)); vhi[dt] = vtr(vs + swz(k1, 2 * dt + (pp >> 1)) + 8 * (pp & 1)); }
#pragma unroll
            for (int dt = 0; dt < 4; ++dt) { const bf16x8 a = (bf16x8){vlo[dt][0], vlo[dt][1], vlo[dt][2], vlo[dt][3], vhi[dt][0], vhi[dt][1], vhi[dt][2], vhi[dt][3]};
                o[dt] = __builtin_amdgcn_mfma_f32_16x16x32_bf16(a, pb, o[dt], 0, 0, 0); } }
    }
    bf16_t* op = OAB + (size_t)(row0 + myr * 64 + qc) * 1024 + 512 + h * 64 + 4 * g;
#pragma unroll
    for (int dt = 0; dt < 4; ++dt) { u32x2 w2; w2.x = cvtpk(o[dt][0] * inv, o[dt][1] * inv); w2.y = cvtpk(o[dt][2] * inv, o[dt][3] * inv); *(u32x2*)(op + 16 * dt) = w2; }
}
__device__ __forceinline__ void unit(const bf16_t* __restrict__ QB, const bf16_t* __restrict__ KB, const bf16_t* __restrict__ VB, bf16_t* __restrict__ OAB, const float* __restrict__ rpb,
                                     NLAS unsigned char* L, int id, int tid, int wave, int lane) {
    long row0; int h, r0, nrows;
    if (id < 1024) { const int pair = id >> 2; row0 = (long)(pair >> 3) * 2048; h = pair & 7; r0 = (id & 3) * 8; nrows = 32; }
    else { const int t = id - 1024; const int pair = t >> 4; row0 = 65536 + (long)(pair >> 3) * 8192; h = pair & 7; r0 = (t & 15) * 8; nrows = 128; }
    NLAS float* rl = (NLAS float*)(L + RPB_OFF);
    if (tid < 512) rl[tid] = ((tid & 31) < 31 && tid < 480) ? rpb[h * 465 + (tid >> 5) * 31 + (tid & 31)] * 1.4426950408889634f : -INFINITY;
    const int key = tid >> 3, chunk = tid & 7; const int so = swz(key, chunk);
    const bf16_t* kg = KB + (size_t)(row0 + key) * 512 + h * 64 + chunk * 8; const bf16_t* vg = VB + (size_t)(row0 + key) * 512 + h * 64 + chunk * 8;
    int rsa = clampi(r0 - 4, 0, nrows - 8), rsb = clampi(r0 + 1 - 4, 0, nrows - 8);
    int lo = rsa, hi = rsb + 7;
    { u32x4 kk[9], vv[9];
#pragma unroll
      for (int w = 0; w < 9; ++w) if (lo + w <= hi) { const size_t off = (size_t)(lo + w) * 64 * 512; kk[w] = *(const u32x4*)(kg + off); vv[w] = *(const u32x4*)(vg + off); }
#pragma unroll
      for (int w = 0; w < 9; ++w) if (lo + w <= hi) { const int sl = ((lo + w) % 9) * 8192; *(NLAS u32x4*)(L + sl + so) = kk[w]; *(NLAS u32x4*)(L + VOFF + sl + so) = vv[w]; } }
    const bf16_t* qg = QB + (size_t)(row0 + 8 * wave + (lane & 7)) * 512 + h * 64 + 8 * (lane >> 4);
    const int qsel = (lane >> 3) & 1;
    bf16x8 q0 = *(const bf16x8*)(qg + (size_t)(r0 + qsel) * 64 * 512), q1 = *(const bf16x8*)(qg + (size_t)(r0 + qsel) * 64 * 512 + 32);
    __syncthreads();
    for (int ra = r0; ra < r0 + 8; ra += 2) {
        const bool more = ra + 2 < r0 + 8;
        const int rsa2 = more ? clampi(ra + 2 - 4, 0, nrows - 8) : rsa, rsb2 = more ? clampi(ra + 3 - 4, 0, nrows - 8) : rsb;
        const int hi2 = rsb2 + 7; const int nnew = hi2 - hi;
        u32x4 kn[2], vn[2]; bf16x8 qn0 = q0, qn1 = q1;
#pragma unroll
        for (int k = 0; k < 2; ++k) { kn[k] = (u32x4){0u, 0u, 0u, 0u}; vn[k] = kn[k]; if (k < nnew) { const size_t off = (size_t)(hi + 1 + k) * 64 * 512; kn[k] = *(const u32x4*)(kg + off); vn[k] = *(const u32x4*)(vg + off); } }
        if (more) { qn0 = *(const bf16x8*)(qg + (size_t)(ra + 2 + qsel) * 64 * 512); qn1 = *(const bf16x8*)(qg + (size_t)(ra + 2 + qsel) * 64 * 512 + 32); }
        step(q0, q1, OAB, rl, L, row0, ra, rsa, rsb, lo, hi - lo + 1, h, wave, lane);
        asm volatile("s_waitcnt lgkmcnt(0)" ::: "memory"); __builtin_amdgcn_s_barrier(); asm volatile("" ::: "memory");
        if (nnew > 0) {
#pragma unroll
            for (int k = 0; k < 2; ++k) if (k < nnew) { const int sl = ((hi + 1 + k) % 9) * 8192; *(NLAS u32x4*)(L + sl + so) = kn[k]; *(NLAS u32x4*)(L + VOFF + sl + so) = vn[k]; }
            asm volatile("s_waitcnt lgkmcnt(0)" ::: "memory"); __builtin_amdgcn_s_barrier(); asm volatile("" ::: "memory"); }
        rsa = rsa2; rsb = rsb2; lo = rsa2; hi = hi2; q0 = qn0; q1 = qn1;
    }
}
#undef NLAS
}
constexpr int NWAVES = 8;
constexpr int M = 81920, MP = 65536, DMODEL = 1024, DIN = 4352, DFF = 2816, DUP = 5632;
constexpr float EPS = 1e-6f;
constexpr size_t MiB = 1u << 20;
constexpr size_t WS_TAB = 1 * MiB, WS_WIN = 2 * MiB, WS_WCAT = 11 * MiB, WS_WOUT = 13 * MiB, WS_WUP = 15 * MiB, WS_WDN = 26 * MiB;
constexpr size_t WS_SS1 = 32 * MiB, WS_SS2 = 37 * MiB, WS_HALO = 42 * MiB;
constexpr size_t WS_XN = 72 * MiB;
constexpr size_t WS_QA = 232 * MiB, WS_KVA = 312 * MiB, WS_QB = 352 * MiB, WS_KB = 432 * MiB, WS_VB = 512 * MiB, WS_GATE = 592 * MiB;
constexpr size_t WS_G = 432 * MiB;
constexpr size_t WS_MIX = 232 * MiB;
constexpr size_t WS_ACT = 432 * MiB;
constexpr size_t WS_END = 912 * MiB;
static_assert(WS_HALO + (size_t)320 * 4 * 5632 * 4 <= WS_XN && WS_ACT + (size_t)M * DFF * 2 <= WS_END && WS_GATE + (size_t)M * 2048 * 2 <= WS_END, "d_ws map");
constexpr int RING_BYTES = 131072, LDS_BYTES = 163840;

#define GAS __attribute__((address_space(1)))
#define LAS __attribute__((address_space(3)))
typedef unsigned short bf16;
typedef unsigned v4u __attribute__((ext_vector_type(4)));
typedef unsigned v2u __attribute__((ext_vector_type(2)));
typedef float f32x4 __attribute__((ext_vector_type(4)));
#define LDS_WAIT() asm volatile("s_waitcnt lgkmcnt(0)" ::: "memory")
__device__ __forceinline__ unsigned pk2(float lo, float hi) { return pg8::cvt_pk_bf16(lo, hi); }
__device__ __forceinline__ float wave_sum(float v) {
#pragma unroll
    for (int o = 1; o < 64; o <<= 1) v += __shfl_xor(v, o);
    return v;
}
__device__ __forceinline__ void p0_transpose_item(const float* W, int N, bf16* WT, int ldk, int koff, int drow0, LAS float* scr, int k0, int n0, int lane) {
#pragma unroll 8
    for (int i = 0; i < 32; ++i) { const int kk = 2 * i + (lane >> 5); scr[kk * 33 + (lane & 31)] = W[(size_t)(k0 + kk) * N + n0 + (lane & 31)]; }
    LDS_WAIT(); asm volatile("" ::: "memory");
    const int c = lane & 7;
#pragma unroll
    for (int j = 0; j < 4; ++j) { const int n = (lane >> 3) + 8 * j; const LAS float* s = scr + (8 * c) * 33 + n;
        v4u o; o.x = pk2(s[0 * 33], s[1 * 33]); o.y = pk2(s[2 * 33], s[3 * 33]); o.z = pk2(s[4 * 33], s[5 * 33]); o.w = pk2(s[6 * 33], s[7 * 33]);
        *(v4u*)(WT + (size_t)(drow0 + n) * ldk + koff + k0 + 8 * c) = o; }
    LDS_WAIT(); asm volatile("" ::: "memory");
}
__device__ __forceinline__ void sincos_d(double x, double& s, double& c) {
    const double k = rint(x * 0.15915494309189533577); const double r = x - k * 6.283185307179586476925; const double r2 = r * r;
    double ts = r, tc = 1.0; s = r; c = 1.0;
#pragma unroll 1
    for (int n = 1; n <= 15; ++n) { ts = -ts * r2 / (double)((2 * n) * (2 * n + 1)); tc = -tc * r2 / (double)((2 * n - 1) * (2 * n)); s += ts; c += tc; }
}
__device__ __forceinline__ const float* xrow(const float* xp, const float* xs, int m) { return m < MP ? xp + (size_t)m * DMODEL : xs + (size_t)(m - MP) * DMODEL; }

#define XB_TMO      128
#define XB_XCNT(j)  (256  + 64 * (j))
#define XB_XSUB(j)  (1280 + 64 * (j))
#define XB_XGEN(j)  (2304 + 64 * (j))
#define XB_TOP      3328
#define XB_TOPGEN   3392
#define XCD_BAR_WORDS 3456
#define XB_SPIN_CAP (1u << 18)

__device__ __forceinline__ unsigned xb_ld(unsigned* p)              { return __hip_atomic_load(p, __ATOMIC_RELAXED, __HIP_MEMORY_SCOPE_AGENT); }
__device__ __forceinline__ unsigned xb_add(unsigned* p, unsigned v) { return __hip_atomic_fetch_add(p, v, __ATOMIC_RELAXED, __HIP_MEMORY_SCOPE_AGENT); }
__device__ __forceinline__ unsigned xb_xcc_id() { return (unsigned)__builtin_amdgcn_s_getreg((3 << 11) | 20) & 0xFu; }
#define XB_SPIN(cond, bar) do { unsigned _sp = 0; while (cond) { __builtin_amdgcn_s_sleep(1); \
    if ((++_sp & 255u) == 0u) { if (xb_ld(&(bar)[XB_TMO])) break; if (_sp > XB_SPIN_CAP) { atomicAdd(&(bar)[XB_TMO], 1u); break; } } } } while (0)

struct XcdBarrier {
    unsigned* bar; unsigned x;
    volatile LAS unsigned* st;
};

__device__ __forceinline__ XcdBarrier xcd_barrier_post(unsigned* bar, volatile LAS unsigned* st) {
    XcdBarrier b; b.bar = bar; b.x = xb_xcc_id(); b.st = st;
    if (threadIdx.x == 0) (void)xb_add(&bar[XB_XCNT(b.x)], 1u);
    return b;
}
__device__ __forceinline__ void xcd_barrier_complete(unsigned* bar, unsigned x, unsigned& nloc, unsigned& nx) {
    const unsigned G = gridDim.x * gridDim.y * gridDim.z;
    unsigned sum, cnt, mine, sp = 0u;
    for (;;) {
        sum = 0u; cnt = 0u; mine = 0u;
#pragma unroll
        for (unsigned j = 0; j < 16; ++j) { const unsigned c = xb_ld(&bar[XB_XCNT(j)]); sum += c; cnt += (c > 0u) ? 1u : 0u; mine = (j == x) ? c : mine; }
        if (sum == G) break;
        __builtin_amdgcn_s_sleep(1);
        if ((++sp & 255u) == 0u) { if (xb_ld(&bar[XB_TMO])) break; if (sp > XB_SPIN_CAP) { atomicAdd(&bar[XB_TMO], 1u); break; } }
    }
    nloc = mine > 0u ? mine : 1u; nx = cnt > 0u ? cnt : 1u;
}

__device__ __forceinline__ void xcd_barrier(const XcdBarrier& b) {
    asm volatile("s_waitcnt vmcnt(0)" ::: "memory");
    __syncthreads();
    if (threadIdx.x == 0) {
        unsigned* bar = b.bar;
        __builtin_amdgcn_s_waitcnt(0);
        unsigned nloc = b.st[0], nx = b.st[1];
        if (nloc == 0u) { xcd_barrier_complete(bar, b.x, nloc, nx); b.st[0] = nloc; b.st[1] = nx; }
        const unsigned old = xb_add(&bar[XB_XSUB(b.x)], 1u);
        const unsigned gen = old / nloc;
        if (old + 1u == (gen + 1u) * nloc) {
            __builtin_amdgcn_fence(__ATOMIC_RELEASE, "agent");
            asm volatile("s_waitcnt vmcnt(0)" ::: "memory");
            const unsigned og = xb_add(&bar[XB_TOP], 1u);
            const unsigned tg = og / nx;
            if (og + 1u == (tg + 1u) * nx) xb_add(&bar[XB_TOPGEN], 1u);
            else XB_SPIN(xb_ld(&bar[XB_TOPGEN]) == tg, bar);
            __builtin_amdgcn_fence(__ATOMIC_ACQUIRE, "agent");
            xb_add(&bar[XB_XGEN(b.x)], 1u);
            asm volatile("s_waitcnt vmcnt(0)" ::: "memory");
        } else {
            XB_SPIN(xb_ld(&bar[XB_XGEN(b.x)]) == gen, bar);
            __builtin_amdgcn_fence(__ATOMIC_ACQUIRE, "agent");
            asm volatile("s_waitcnt vmcnt(0)" ::: "memory");
        }
    }
    __syncthreads();
}

struct Args { const float* in[18]; float* out; unsigned char* ws; int ph_lo, ph_hi; };
enum { I_XP = 0, I_XS, I_PREMIX, I_WIN, I_BGATE, I_QN, I_KN, I_RPB, I_WPA, I_WPB, I_WOUT, I_POSTMIX, I_PREFFN, I_WUP, I_CW, I_CB, I_WDN, I_POSTFFN };
constexpr int NPHASE = 11;

__global__ void __launch_bounds__(NWAVES * 64, 2) enc_fwd(Args args) {
    extern __shared__ __attribute__((aligned(16))) unsigned char lds[];
    cg::grid_group grid = cg::this_grid();
    const int tid = threadIdx.x, lane = tid & 63, wave = __builtin_amdgcn_readfirstlane(tid >> 6);
    const int G = gridDim.x; const int bx = blockIdx.x; const int vcu = (G % 8 == 0) ? (bx % 8) * (G / 8) + bx / 8 : bx;
    const int gw = vcu * NWAVES + wave, NGW = G * NWAVES;
    unsigned char* ws = args.ws;
    LAS unsigned char* L = (LAS unsigned char*)lds;
    const float* xp = args.in[I_XP]; const float* xs = args.in[I_XS];
    bf16* Win_t = (bf16*)(ws + WS_WIN); bf16* Wcat_t = (bf16*)(ws + WS_WCAT); bf16* Wout_t = (bf16*)(ws + WS_WOUT); bf16* Wup_t = (bf16*)(ws + WS_WUP); bf16* Wdn_t = (bf16*)(ws + WS_WDN);
    float* TAB = (float*)(ws + WS_TAB); float* SS1 = (float*)(ws + WS_SS1); float* SS2 = (float*)(ws + WS_SS2); float* HALO = (float*)(ws + WS_HALO);
    bf16* XN = (bf16*)(ws + WS_XN); bf16* QA = (bf16*)(ws + WS_QA); bf16* KVA = (bf16*)(ws + WS_KVA); bf16* QB = (bf16*)(ws + WS_QB); bf16* KB = (bf16*)(ws + WS_KB); bf16* VB = (bf16*)(ws + WS_VB);
    bf16* GATE = (bf16*)(ws + WS_GATE); bf16* GM = (bf16*)(ws + WS_G); bf16* MIX = (bf16*)(ws + WS_MIX); bf16* ACT = (bf16*)(ws + WS_ACT);
    const int lo = args.ph_lo, hi = args.ph_hi;
#ifndef PH_MASK
#define PH_MASK 0x7ff
#endif
#define IN(k) (((PH_MASK >> (k)) & 1) && lo <= (k) && (k) < hi)
#define SEAM(k) do { if (IN(k) && hi > (k) + 1) xcd_barrier(bar); } while (0)
    if (hi > 1000) grid.sync();
    { volatile LAS unsigned* st = (volatile LAS unsigned*)(L + LDS_BYTES - 64); if (tid < 16) st[tid] = 0u; }
    __syncthreads();
    XcdBarrier bar = xcd_barrier_post((unsigned*)ws, (volatile LAS unsigned*)(L + LDS_BYTES - 64));
#if defined(PROBE_A)
    unsigned long long t_a = 0, t_b = 0, t_c = 0, t_d = 0;
#define STAMP(i) do { if ((i) == PROBE_A) t_a = __builtin_amdgcn_s_memrealtime(); if ((i) == PROBE_B) t_b = __builtin_amdgcn_s_memrealtime(); if ((i) == PROBE_C) t_c = __builtin_amdgcn_s_memrealtime(); if ((i) == PROBE_D) t_d = __builtin_amdgcn_s_memrealtime(); } while (0)
#else
#define STAMP(i) do {} while (0)
#endif
    STAMP(0);

    if (IN(0)) {
        LAS float* scr = (LAS float*)(L + wave * 16384);
        constexpr int I_IN = 16 * 136, I_PA = 8 * 32, I_OUT = 16 * 32, I_UP = 16 * 176, I_DN = 44 * 32;
        constexpr int NITEMS = I_IN + 2 * I_PA + I_OUT + I_UP + I_DN;
        for (int it = gw; it < NITEMS; it += NGW) {
            int r = it;
            if (r < I_IN) { const int kb = r / 136, nb = r % 136; p0_transpose_item(args.in[I_WIN], DIN, Win_t, 1024, 0, 32 * nb, scr, 64 * kb, 32 * nb, lane); continue; } r -= I_IN;
            if (r < I_PA) { const int kb = r / 32, nb = r % 32; p0_transpose_item(args.in[I_WPA], 1024, Wcat_t, 1024, 0, 32 * nb, scr, 64 * kb, 32 * nb, lane); continue; } r -= I_PA;
            if (r < I_PA) { const int kb = r / 32, nb = r % 32; p0_transpose_item(args.in[I_WPB], 1024, Wcat_t, 1024, 512, 32 * nb, scr, 64 * kb, 32 * nb, lane); continue; } r -= I_PA;
            if (r < I_OUT) { const int kb = r / 32, nb = r % 32; p0_transpose_item(args.in[I_WOUT], 1024, Wout_t, 1024, 0, 32 * nb, scr, 64 * kb, 32 * nb, lane); continue; } r -= I_OUT;
            if (r < I_UP) { const int kb = r / 176, nb = r % 176; const int n0 = 32 * nb; const int nn = n0 < DFF ? n0 : n0 - DFF;
                const int drow = 256 * (nn / 128) + (n0 < DFF ? 0 : 128) + (nn % 128);
                p0_transpose_item(args.in[I_WUP], DUP, Wup_t, 1024, 0, drow, scr, 64 * kb, n0, lane); continue; } r -= I_UP;
            { const int kb = r / 32, nb = r % 32; p0_transpose_item(args.in[I_WDN], 1024, Wdn_t, DFF, 0, 32 * nb, scr, 64 * kb, 32 * nb, lane); }
        }
        { const v4u z4 = {0u, 0u, 0u, 0u}; const int gid0 = bx * (NWAVES * 64) + tid, NT0 = G * NWAVES * 64;
          for (int i = gid0; i < (int)((size_t)M * 4 * 8 * 2 / 16); i += NT0) ((v4u*)SS1)[i] = z4;
          for (int i = gid0; i < (int)((size_t)M * 4 * 8 / 16); i += NT0) ((v4u*)SS2)[i] = z4; }
        { const int gid = bx * (NWAVES * 64) + tid;
          if (gid < 2048) { const int pos = gid >> 4, i = gid & 15; const float fr = exp2f(-(float)i * (13.287712379549449f / 16.0f)); const float ang = (float)pos * fr;
              double s, c; sincos_d((double)ang, s, c); TAB[gid] = (float)c; TAB[2048 + gid] = (float)s; } }
        const float* gw1 = args.in[I_PREMIX];
        for (int m = gw; m < M; m += NGW) {
            const f32x4* xr = (const f32x4*)xrow(xp, xs, m) + lane; f32x4 v[4]; float s2 = 0.f;
#pragma unroll
            for (int j = 0; j < 4; ++j) { v[j] = xr[64 * j]; s2 += (v[j].x * v[j].x + v[j].y * v[j].y) + (v[j].z * v[j].z + v[j].w * v[j].w); }
            const float rstd = 1.0f / sqrtf(wave_sum(s2) * (1.f / DMODEL) + EPS);
            v2u* o8 = (v2u*)(XN + (size_t)m * DMODEL) + lane;
#pragma unroll
            for (int j = 0; j < 4; ++j) { const f32x4 w = ((const f32x4*)gw1)[64 * j + lane]; v2u o; o.x = pk2(v[j].x * rstd * w.x, v[j].y * rstd * w.y); o.y = pk2(v[j].z * rstd * w.z, v[j].w * rstd * w.w); o8[64 * j] = o; }
        }
    }
    SEAM(0); STAMP(1);
    if (IN(1)) {
        pg8::Gemm g{XN, Win_t, M, DIN, DMODEL, DMODEL, DMODEL}; pg8::StaticOrder S; S.init(M, DIN, G, bx);
        pg8::EpiIn E{QA, KVA, QB, KB, VB, GATE, args.in[I_BGATE], args.in[I_QN], args.in[I_KN], TAB};
        pg8::gemm_phase<pg8::EpiIn, pg8::StaticOrder>(L, g, S, E);
    }
    SEAM(1); STAMP(2);
    if (IN(3)) {
        const attn_body::bf16* Qp = (const attn_body::bf16*)QA; const attn_body::bf16* Kp = (const attn_body::bf16*)KVA; const attn_body::bf16* Vp = (const attn_body::bf16*)(KVA + 128);
        attn_body::bf16* Op = (attn_body::bf16*)XN;
        for (int u = vcu; u < 2048; u += G) { int qb = u >> 8, bh = u & 255; if (G == 256) { bh = (vcu & ~7) + (u >> 8); qb = vcu & 7; } attn_body::attn_unit<8>((long)(bh >> 3) * 2048, 32, bh & 7, qb * 256, Qp, Kp, Vp, Op, (char*)lds); }
        for (int u = vcu; u < 512; u += G) { const int bh = (u & 255) >> 4, qb = ((u & 15) << 1) | (u >> 8); attn_body::attn_unit<8>((long)MP + (long)(bh >> 3) * 8192, 128, bh & 7, qb * 256, Qp, Kp, Vp, Op, (char*)lds); }
        __syncthreads(); STAMP(4);
        for (int id = vcu; id < 1280; id += G) nat::unit(QB, KB, VB, XN, args.in[I_RPB], L, id, tid, wave, lane);
        __syncthreads();
    }
    SEAM(3); STAMP(5);
    if (IN(4)) {
        pg8::Gemm g{XN, Wcat_t, M, DMODEL, 512, DMODEL, DMODEL}; pg8::ChainOrder S; S.base.init(M, DMODEL, G, bx); S.seg_bytes = 1024;
        pg8::EpiMerge E{GATE, GM};
        pg8::gemm_phase<pg8::EpiMerge, pg8::ChainOrder>(L, g, S, E);
    }
    SEAM(4); STAMP(6);
    if (IN(5)) {
        pg8::Gemm g{GM, Wout_t, M, DMODEL, DMODEL, DMODEL, DMODEL}; pg8::StaticOrder S; S.init(M, DMODEL, G, bx);
        pg8::EpiNorm<0> E{{(unsigned long long*)SS1}, {(unsigned long long*)SS1 + (size_t)M * 4}, xp, xs, args.out, args.in[I_POSTMIX], args.in[I_PREFFN], XN, MIX};
        pg8::gemm_phase<pg8::EpiNorm<0>, pg8::StaticOrder>(L, g, S, E);
    }
    SEAM(5); STAMP(7);
    if (IN(7)) {
        pg8::Gemm g{XN, Wup_t, M, DUP, DMODEL, DMODEL, DMODEL}; pg8::StaticOrder S; S.init(M, DUP, G, bx);
        pg8::EpiConv E{ACT, HALO, args.in[I_CW], args.in[I_CB]};
        pg8::gemm_phase<pg8::EpiConv, pg8::StaticOrder>(L, g, S, E);
    }
    SEAM(7); STAMP(9);
    if (IN(8)) {
        const float* cw = args.in[I_CW]; const float* cb = args.in[I_CB];
        const int gt = (vcu * NWAVES + wave) * 64 + lane, NGT = NGW * 64;
        for (int idx = gt; idx < 320 * 2 * (DFF / 4); idx += NGT) {
            const int q4 = idx % (DFF / 4), e = (idx / (DFF / 4)) & 1, pm = idx / (2 * (DFF / 4)); const int ca = q4 * 4;
            const int hc = (ca >> 7) * 256 + (ca & 127);
            const bool seq_first = pm < 256 ? (pm & 7) == 0 : ((pm - 256) & 31) == 0;
            const bool seq_last = pm < 256 ? (pm & 7) == 7 : ((pm - 256) & 31) == 31;
            const float* hp = HALO + (size_t)pm * 4 * 5632;
            f32x4 cv[2]; const f32x4 z = (f32x4){0.f, 0.f, 0.f, 0.f};
#pragma unroll
            for (int bj = 0; bj < 2; ++bj) { const int c = hc + bj * 128; f32x4 up, cur, dn;
                if (e == 0) { up = seq_first ? z : *(const f32x4*)(hp - 5632 + c); cur = *(const f32x4*)(hp + c); dn = *(const f32x4*)(hp + 5632 + c); }
                else { up = *(const f32x4*)(hp + 2 * 5632 + c); cur = *(const f32x4*)(hp + 3 * 5632 + c); dn = seq_last ? z : *(const f32x4*)(hp + 4 * 5632 + c); }
                const int wcx = bj * DFF + ca;
                cv[bj] = *(const f32x4*)(cw + wcx) * up + *(const f32x4*)(cw + DUP + wcx) * cur + *(const f32x4*)(cw + 2 * DUP + wcx) * dn + *(const f32x4*)(cb + wcx); }
            v2u o; o.x = pk2(pg8::gelu_tanh_f(cv[0][0]) * cv[1][0], pg8::gelu_tanh_f(cv[0][1]) * cv[1][1]); o.y = pk2(pg8::gelu_tanh_f(cv[0][2]) * cv[1][2], pg8::gelu_tanh_f(cv[0][3]) * cv[1][3]);
            *(v2u*)(ACT + (size_t)(pm * 256 + (e ? 255 : 0)) * DFF + ca) = o;
        }
    }
    SEAM(8); STAMP(10);
    if (IN(9)) {
        pg8::Gemm g{ACT, Wdn_t, M, DMODEL, DFF, DFF, DFF}; pg8::StaticOrder S; S.init(M, DMODEL, G, bx);
        pg8::EpiNorm<1> E{{(unsigned long long*)SS2}, {nullptr}, xp, xs, args.out, args.in[I_POSTFFN], nullptr, nullptr, MIX};
        pg8::gemm_phase<pg8::EpiNorm<1>, pg8::StaticOrder>(L, g, S, E);
    }
    STAMP(12);
#if defined(PROBE_A)
    __syncthreads();
    if (bx == 0 && tid == 0) { args.out[0] += (float)(t_b - t_a) * 0.01f; args.out[(size_t)MP * DMODEL] += (float)(t_d - t_c) * 0.01f; }
#endif
#undef IN
#undef SEAM
}

#ifndef MK_N_LAUNCHES
#define MK_N_LAUNCHES 1
#endif
extern "C" void kernel_launch(void* const* d_in, const int* in_sizes, int n_in, void* d_out, int out_size, void* d_ws, size_t ws_size, hipStream_t stream) {
    static int grid = 0;
    if (grid == 0) {
        if (n_in != 18 || in_sizes[0] != MP * DMODEL || out_size != M * DMODEL || ws_size < WS_END) { fprintf(stderr, "kernel_launch: unexpected shapes (n_in %d, in0 %d, out %d, ws %zu); nothing launched\n", n_in, n_in > 0 ? in_sizes[0] : -1, out_size, ws_size); grid = -1; return; }
        int dev = 0, cus = 0, per_cu = 0;
        if (hipGetDevice(&dev) != hipSuccess || hipDeviceGetAttribute(&cus, hipDeviceAttributeMultiprocessorCount, dev) != hipSuccess) { grid = -1; return; }
        if (hipFuncSetAttribute((const void*)enc_fwd, hipFuncAttributeMaxDynamicSharedMemorySize, LDS_BYTES) != hipSuccess) { fprintf(stderr, "kernel_launch: hipFuncSetAttribute failed\n"); grid = -1; return; }
        if (hipOccupancyMaxActiveBlocksPerMultiprocessor(&per_cu, (const void*)enc_fwd, NWAVES * 64, LDS_BYTES) != hipSuccess || per_cu < 1) { fprintf(stderr, "kernel_launch: occupancy query gave %d\n", per_cu); per_cu = 1; }
        (void)hipGetLastError();
        grid = cus * per_cu;
    }
    if (grid < 0) return;
    Args a{};
    for (int i = 0; i < 18; ++i) a.in[i] = (const float*)d_in[i];
    a.out = (float*)d_out; a.ws = (unsigned char*)d_ws;
#if MK_N_LAUNCHES == 1
    if (hipMemsetAsync(d_ws, 0, 16384, stream) != hipSuccess) { fprintf(stderr, "kernel_launch: memset failed\n"); return; }
    a.ph_lo = 0; a.ph_hi = NPHASE;
    void* kargs[] = {&a};
    const hipError_t e = hipLaunchCooperativeKernel((const void*)enc_fwd, dim3(grid), dim3(NWAVES * 64), kargs, LDS_BYTES, stream);
    if (e != hipSuccess) fprintf(stderr, "kernel_launch: cooperative launch failed: %s (grid %d)\n", hipGetErrorString(e), grid);
#else
    for (int p = 0; p < NPHASE; ++p) { a.ph_lo = p; a.ph_hi = p + 1; hipLaunchKernelGGL(enc_fwd, dim3(grid), dim3(NWAVES * 64), LDS_BYTES, stream, a); }
#endif
}
```

```cpp
#include <hip/hip_runtime.h>
#include <hip/hip_cooperative_groups.h>
#include <hip/hip_bf16.h>
#include <cstdio>
#include <cstdint>
#include <cmath>
namespace cg = cooperative_groups;
namespace pg8 {
#define PG8_LAS __attribute__((address_space(3)))
typedef unsigned short bf16_t;
typedef short bf16x8 __attribute__((ext_vector_type(8)));
typedef float f32x4 __attribute__((ext_vector_type(4)));
typedef unsigned u32x4 __attribute__((ext_vector_type(4)));
constexpr int BM = 256, BK = 64, HALF = 128, HTB = HALF * BK * 2  , STAGE_BYTES = 8 * HTB, NXCD = 8, WGM = 8;

__host__ __device__ __forceinline__ int lds_byte(int r, int c) { const int st = (r >> 4) * 2 + (c >> 5), rr = r & 15, cc = c & 31, ob = rr * 64 + cc * 2; return st * 1024 + (ob ^ (((ob >> 9) & 1) << 5)); }
__host__ __device__ __forceinline__ void stage_rc(int b, int& R, int& C) { const int st = b / 1024, sb = b % 1024, swz = sb ^ (((sb >> 9) & 1) << 5); R = (st >> 1) * 16 + swz / 64; C = (st & 1) * 32 + (swz % 64) / 2; }
__host__ __device__ __forceinline__ int perm32(int rho) { const int n = rho >> 4, i = rho & 15; return 8 * (i >> 2) + 4 * n + (i & 3); }

struct Unit { int pm, pn, ko; };
struct Gemm { const bf16_t* A; const bf16_t* Bt; int M, N, K, lda, ldb; };

struct StaticOrder {
    int nM, nN, nwg, G, c;
    __host__ __device__ void init(int M, int N, int G_, int c_) { nM = M / BM; nN = N / BM; nwg = nM * nN; G = G_; c = c_; }
    __host__ __device__ bool next(int i, Unit& u) const {
        const long L = (long)i * G + c; if (L >= nwg) return false;
        int wgid = (int)L; { const int q = nwg / NXCD, r = nwg % NXCD, xcd = wgid % NXCD, off = wgid / NXCD; wgid = (xcd < r ? xcd * (q + 1) : r * (q + 1) + (xcd - r) * q) + off; }
        const int nig = WGM * nN, gid = wgid / nig, fm = gid * WGM, gsz = (nM - fm) < WGM ? (nM - fm) : WGM;
        u.pm = fm + ((wgid % nig) % gsz); u.pn = (wgid % nig) / gsz; u.ko = 0; return true;
    }
    __device__ __forceinline__ void a_ready(const Unit&) const {}
    __device__ __forceinline__ void done(const Unit&) const {}
};
struct ChainOrder {
    StaticOrder base; int seg_bytes;
    __host__ __device__ bool next(int i, Unit& u) const { const bool ok = base.next(i >> 1, u); u.ko = (i & 1) * seg_bytes; return ok; }
    __device__ __forceinline__ void a_ready(const Unit&) const {}
    __device__ __forceinline__ void done(const Unit&) const {}
};

__device__ __forceinline__ unsigned cvt_pk_bf16(float lo, float hi) { unsigned r; asm volatile("v_cvt_pk_bf16_f32 %0, %1, %2" : "=v"(r) : "v"(lo), "v"(hi)); return r; }
typedef float f32x2 __attribute__((ext_vector_type(2)));
__device__ __forceinline__ float bf_lo(unsigned w) { return __uint_as_float(w << 16); }
__device__ __forceinline__ float bf_hi(unsigned w) { return __uint_as_float(w & 0xffff0000u); }
__device__ __forceinline__ float sigmoid_f(float z) { return __builtin_amdgcn_rcpf(1.0f + __builtin_amdgcn_exp2f(-1.4426950408889634f * z)); }
__device__ __forceinline__ float gelu_tanh_f(float x) {
    const float t = x * (1.0f + 0.044715f * x * x);
    return x * __builtin_amdgcn_rcpf(1.0f + __builtin_amdgcn_exp2f(-2.302208198f * t));
}
__device__ __forceinline__ u32x4 pack8(const f32x4 v0, const f32x4 v1) { u32x4 w; w.x = cvt_pk_bf16(v0[0], v0[1]); w.y = cvt_pk_bf16(v0[2], v0[3]); w.z = cvt_pk_bf16(v1[0], v1[1]); w.w = cvt_pk_bf16(v1[2], v1[3]); return w; }

struct EpiIn {
    static constexpr bool PERM = true, AFTER_DRAIN = false, CHAIN = false;
    bf16_t *QA, *KVA, *QB, *KB, *VB, *GATE; const float* bgate; const float* qn; const float* kn; const float* tab;
    __device__ __forceinline__ void operator()(const f32x4 (&acc)[2][2][4][2], const Unit& u, int wr, int wc, int fr, int fq, PG8_LAS unsigned char*) const {
        const int pn = u.pn; bf16_t* base; int ldc, colt; bool sig = false; float osc = 1.0f;
        if (pn < 2) { base = QA; ldc = 512; colt = pn * 256; }
        else if (pn == 2) { base = KVA; ldc = 256; colt = 0; }
        else if (pn < 5) { base = QB; ldc = 512; colt = (pn - 3) * 256; osc = 0.125f * 1.4426950408889634f; }
        else if (pn < 7) { base = KB; ldc = 512; colt = (pn - 5) * 256; }
        else if (pn < 9) { base = VB; ldc = 512; colt = (pn - 7) * 256; }
        else { base = GATE; ldc = 2048; colt = (pn - 9) * 256; sig = true; }
        const int row0 = u.pm * BM + wr * 64 + fr, col0 = colt + wc * 32 + 8 * fq;
        f32x4 bv[2][2];
#pragma unroll
        for (int bj = 0; bj < 2; ++bj)
#pragma unroll
            for (int n = 0; n < 2; ++n) bv[bj][n] = sig ? *(const f32x4*)(bgate + col0 + bj * HALF + 4 * n) : (f32x4){0.f, 0.f, 0.f, 0.f};
#pragma unroll
        for (int ai = 0; ai < 2; ++ai)
#pragma unroll
            for (int m = 0; m < 4; ++m) { bf16_t* rowp = base + (size_t)(row0 + ai * HALF + m * 16) * ldc + col0;
#pragma unroll
                for (int bj = 0; bj < 2; ++bj) { f32x4 v0 = acc[ai][bj][m][0] + bv[bj][0], v1 = acc[ai][bj][m][1] + bv[bj][1];
                    if (sig) {
#pragma unroll
                        for (int i = 0; i < 4; ++i) { v0[i] = sigmoid_f(v0[i]); v1[i] = sigmoid_f(v1[i]); } }
                    *(u32x4*)(rowp + bj * HALF) = pack8(v0 * osc, v1 * osc); } }
        if (pn > 2) return;
        asm volatile("s_waitcnt vmcnt(0)" ::: "memory"); __builtin_amdgcn_s_barrier(); asm volatile("" ::: "memory");
        const int nh = pn == 2 ? 2 : 4; const float* nw0 = pn == 2 ? kn : qn; const float sc = pn == 2 ? 1.0f : 0.125f * 1.4426950408889634f;
        for (int idx = threadIdx.x; idx < 256 * nh * 2; idx += 1024) {
            u32x4 raw[2][4]; bf16_t* p[2]; int pos[2]; float ss[2];
#pragma unroll
            for (int k = 0; k < 2; ++k) { const int id = idx + 512 * k; const int half = id & 1, hh = (id >> 1) & (nh - 1), r = pn == 2 ? (id >> 2) : (id >> 3); const int row = u.pm * BM + r;
                p[k] = base + (size_t)row * ldc + colt + hh * 64 + half * 32;
                const int t = row < 65536 ? (row & 2047) : ((row - 65536) & 8191); pos[k] = half ? (t & 63) : (t >> 6);
#pragma unroll
                for (int c = 0; c < 4; ++c) raw[k][c] = ((const u32x4*)p[k])[c]; }
            const float* nw = nw0 + (idx & 1) * 32;
            f32x4 nwv[8];
#pragma unroll
            for (int c = 0; c < 8; ++c) nwv[c] = ((const f32x4*)nw)[c];
#pragma unroll
            for (int k = 0; k < 2; ++k) {
                f32x4 ct[4], st[4];
#pragma unroll
                for (int c = 0; c < 4; ++c) { ct[c] = ((const f32x4*)(tab + pos[k] * 16))[c]; st[c] = ((const f32x4*)(tab + 2048 + pos[k] * 16))[c]; }
                float x[32]; float s2 = 0.f;
#pragma unroll
                for (int c = 0; c < 4; ++c)
#pragma unroll
                    for (int e = 0; e < 4; ++e) { const unsigned w = raw[k][c][e]; x[c * 8 + e * 2] = bf_lo(w); x[c * 8 + e * 2 + 1] = bf_hi(w); }
#pragma unroll
                for (int i = 0; i < 32; ++i) s2 += x[i] * x[i];
                s2 += __shfl_xor(s2, 1);
                const float rstd = sc / sqrtf(s2 * (1.f / 64.f) + 1e-6f);
                float y[32];
#pragma unroll
                for (int i = 0; i < 16; ++i) { const float a = x[i] * rstd * nwv[i >> 2][i & 3], b = x[i + 16] * rstd * nwv[4 + (i >> 2)][i & 3]; const float c = ct[i >> 2][i & 3], sn = st[i >> 2][i & 3];
                    y[i] = a * c - b * sn; y[i + 16] = b * c + a * sn; }
#pragma unroll
                for (int c = 0; c < 4; ++c) { u32x4 o; o.x = cvt_pk_bf16(y[c * 8], y[c * 8 + 1]); o.y = cvt_pk_bf16(y[c * 8 + 2], y[c * 8 + 3]); o.z = cvt_pk_bf16(y[c * 8 + 4], y[c * 8 + 5]); o.w = cvt_pk_bf16(y[c * 8 + 6], y[c * 8 + 7]); ((u32x4*)p[k])[c] = o; }
            }
        }
    }
};

struct EpiMerge {
    static constexpr bool PERM = true, AFTER_DRAIN = false, CHAIN = true;
    const bf16_t* GATE; bf16_t* G;
    __device__ __forceinline__ void mid(f32x4 (&acc)[2][2][4][2], const Unit& u, int wr, int wc, int fr, int fq) const {
        const int row0 = u.pm * BM + wr * 64 + fr, col0 = u.pn * BM + wc * 32 + 8 * fq;
#pragma unroll
        for (int ai = 0; ai < 2; ++ai)
#pragma unroll
            for (int m = 0; m < 4; ++m) { const bf16_t* gp = GATE + (size_t)(row0 + ai * HALF + m * 16) * 2048 + col0;
#pragma unroll
                for (int bj = 0; bj < 2; ++bj) { const u32x4 ga = *(const u32x4*)(gp + bj * HALF), gb = *(const u32x4*)(gp + 1024 + bj * HALF);
#pragma unroll
                    for (int n = 0; n < 2; ++n) { const unsigned a0 = n ? ga.z : ga.x, a1 = n ? ga.w : ga.y, b0 = n ? gb.z : gb.x, b1 = n ? gb.w : gb.y;
                        f32x4 r; r[0] = bf_lo(a0) * __builtin_amdgcn_rcpf(bf_lo(b0)); r[1] = bf_hi(a0) * __builtin_amdgcn_rcpf(bf_hi(b0));
                        r[2] = bf_lo(a1) * __builtin_amdgcn_rcpf(bf_lo(b1)); r[3] = bf_hi(a1) * __builtin_amdgcn_rcpf(bf_hi(b1));
                        acc[ai][bj][m][n] = acc[ai][bj][m][n] * r; } }
                if (m == 3) asm volatile("" ::: "memory"); }
    }
    __device__ __forceinline__ void operator()(f32x4 (&acc)[2][2][4][2], const Unit& u, int wr, int wc, int fr, int fq, PG8_LAS unsigned char*) const {
        if (u.ko == 0) { mid(acc, u, wr, wc, fr, fq); return; }
        const int row0 = u.pm * BM + wr * 64 + fr, col0 = u.pn * BM + wc * 32 + 8 * fq;
#pragma unroll
        for (int ai = 0; ai < 2; ++ai)
#pragma unroll
            for (int m = 0; m < 4; ++m) { const size_t r = (size_t)(row0 + ai * HALF + m * 16);
#pragma unroll
                for (int bj = 0; bj < 2; ++bj) { const u32x4 gb = *(const u32x4*)(GATE + r * 2048 + 1024 + col0 + bj * HALF);
                    f32x4 v0 = acc[ai][bj][m][0], v1 = acc[ai][bj][m][1];
                    v0[0] *= bf_lo(gb.x); v0[1] *= bf_hi(gb.x); v0[2] *= bf_lo(gb.y); v0[3] *= bf_hi(gb.y);
                    v1[0] *= bf_lo(gb.z); v1[1] *= bf_hi(gb.z); v1[2] *= bf_lo(gb.w); v1[3] *= bf_hi(gb.w);
                    *(u32x4*)(G + r * 1024 + col0 + bj * HALF) = pack8(v0, v1); } }
    }
};

struct EpiSS {
    static constexpr bool PERM = true, AFTER_DRAIN = false, CHAIN = false;
    bf16_t* O; float* SS;
    __device__ __forceinline__ void operator()(const f32x4 (&acc)[2][2][4][2], const Unit& u, int wr, int wc, int fr, int fq, PG8_LAS unsigned char*) const {
        const int row0 = u.pm * BM + wr * 64 + fr, col0 = u.pn * BM + wc * 32 + 8 * fq;
#pragma unroll
        for (int ai = 0; ai < 2; ++ai)
#pragma unroll
            for (int m = 0; m < 4; ++m) { const size_t r = (size_t)(row0 + ai * HALF + m * 16); float s = 0.f;
#pragma unroll
                for (int bj = 0; bj < 2; ++bj) { const f32x4 v0 = acc[ai][bj][m][0], v1 = acc[ai][bj][m][1];
                    s += (v0[0] * v0[0] + v0[1] * v0[1]) + (v0[2] * v0[2] + v0[3] * v0[3]) + (v1[0] * v1[0] + v1[1] * v1[1]) + (v1[2] * v1[2] + v1[3] * v1[3]);
                    *(u32x4*)(O + r * 1024 + col0 + bj * HALF) = pack8(v0, v1); }
                s += __shfl_xor(s, 16); s += __shfl_xor(s, 32);
                if (fq == 0) SS[r * 16 + u.pn * 4 + wc] = s; }
    }
};

struct RowExchange {
    unsigned long long* xs;
    __device__ __forceinline__ void run(const float (&ps)[2][4], float (&rs)[2][4], const Unit& u, int wr, int wc, int fr, int fq, PG8_LAS unsigned char* lds) const {
        PG8_LAS float* P = (PG8_LAS float*)(lds + 131072); PG8_LAS float* R = P + 1024;
        const int tid = threadIdx.x;
#pragma unroll
        for (int ai = 0; ai < 2; ++ai)
#pragma unroll
            for (int m = 0; m < 4; ++m) { float t = ps[ai][m]; t += __shfl_xor(t, 16); t += __shfl_xor(t, 32); if (fq == 0) P[(ai * HALF + wr * 64 + m * 16 + fr) * 4 + wc] = t; }
        asm volatile("s_waitcnt lgkmcnt(0)" ::: "memory"); __builtin_amdgcn_s_barrier(); asm volatile("" ::: "memory");
        if (tid < 256) { const f32x4 p = *(const PG8_LAS f32x4*)(P + tid * 4); const float mine = (p[0] + p[1]) + (p[2] + p[3]);
            unsigned long long* sl = xs + ((size_t)u.pm * BM + tid) * 4;
            __hip_atomic_store(sl + u.pn, ((unsigned long long)1u << 32) | (unsigned long long)__float_as_uint(mine), __ATOMIC_RELAXED, __HIP_MEMORY_SCOPE_AGENT);
            float tot = 0.f; unsigned got = 0u; unsigned spins = 0;
            while (got != 15u) {
#pragma unroll
                for (int t = 0; t < 4; ++t) if (!((got >> t) & 1u)) { const unsigned long long v = __hip_atomic_load(sl + t, __ATOMIC_RELAXED, __HIP_MEMORY_SCOPE_AGENT);
                    if ((unsigned)(v >> 32) == 1u) { tot += __uint_as_float((unsigned)v); got |= 1u << t; } }
                if (got != 15u) { __builtin_amdgcn_s_sleep(1); if (++spins > (1u << 20)) break; } }
            R[tid] = 1.0f / sqrtf(tot * (1.f / 1024.f) + 1e-6f); }
        asm volatile("s_waitcnt vmcnt(0) lgkmcnt(0)" ::: "memory"); __builtin_amdgcn_s_barrier(); asm volatile("" ::: "memory");
#pragma unroll
        for (int ai = 0; ai < 2; ++ai)
#pragma unroll
            for (int m = 0; m < 4; ++m) rs[ai][m] = R[ai * HALF + wr * 64 + m * 16 + fr];
    }
};
__device__ __forceinline__ float sq4(const f32x4 v) { return (v[0] * v[0] + v[1] * v[1]) + (v[2] * v[2] + v[3] * v[3]); }
template <int MODE> struct EpiNorm {
    static constexpr bool PERM = true, AFTER_DRAIN = false, CHAIN = false;
    RowExchange ex1, ex2; const float* xp; const float* xs; float* out; const float* w1; const float* w2; bf16_t* XN2; bf16_t* X1B;
    __device__ __forceinline__ void operator()(f32x4 (&acc)[2][2][4][2], const Unit& u, int wr, int wc, int fr, int fq, PG8_LAS unsigned char* lds) const {
        const int row0 = u.pm * BM + wr * 64 + fr, col0 = u.pn * BM + wc * 32 + 8 * fq;
        float ps[2][4], rs[2][4];
#pragma unroll
        for (int ai = 0; ai < 2; ++ai)
#pragma unroll
            for (int m = 0; m < 4; ++m) ps[ai][m] = (sq4(acc[ai][0][m][0]) + sq4(acc[ai][0][m][1])) + (sq4(acc[ai][1][m][0]) + sq4(acc[ai][1][m][1]));
        ex1.run(ps, rs, u, wr, wc, fr, fq, lds);
        const float* xin = xp; if (MODE == 0) xin = u.pm < 256 ? xp + (size_t)u.pm * BM * 1024 : xs + (size_t)(u.pm - 256) * BM * 1024;
        float* xo = out + (size_t)u.pm * BM * 1024; bf16_t* xb = X1B + (size_t)u.pm * BM * 1024;
        const int lr0 = wr * 64 + fr;
        f32x4 wv[2][2];
#pragma unroll
        for (int bj = 0; bj < 2; ++bj)
#pragma unroll
            for (int n = 0; n < 2; ++n) wv[bj][n] = *(const f32x4*)(w1 + col0 + bj * HALF + 4 * n);
#pragma unroll
        for (int ai = 0; ai < 2; ++ai)
#pragma unroll
            for (int m = 0; m < 4; ++m) { const size_t ro = (size_t)(lr0 + ai * HALF + m * 16) * 1024 + col0; const float r1 = rs[ai][m]; float s2 = 0.f;
#pragma unroll
                for (int bj = 0; bj < 2; ++bj) {
                    if (MODE == 0) { const f32x4 x0 = *(const f32x4*)(xin + ro + bj * HALF), x1 = *(const f32x4*)(xin + ro + bj * HALF + 4);
                        const f32x4 v0 = x0 + acc[ai][bj][m][0] * r1 * wv[bj][0], v1 = x1 + acc[ai][bj][m][1] * r1 * wv[bj][1];
                        acc[ai][bj][m][0] = v0; acc[ai][bj][m][1] = v1; s2 += sq4(v0) + sq4(v1);
                        *(u32x4*)(xb + ro + bj * HALF) = pack8(v0, v1);
                    } else { const u32x4 rw = *(const u32x4*)(xb + ro + bj * HALF);
                        const f32x4 x0 = (f32x4){bf_lo(rw.x), bf_hi(rw.x), bf_lo(rw.y), bf_hi(rw.y)}, x1 = (f32x4){bf_lo(rw.z), bf_hi(rw.z), bf_lo(rw.w), bf_hi(rw.w)};
                        *(f32x4*)(xo + ro + bj * HALF) = x0 + acc[ai][bj][m][0] * r1 * wv[bj][0];
                        *(f32x4*)(xo + ro + bj * HALF + 4) = x1 + acc[ai][bj][m][1] * r1 * wv[bj][1]; } }
                ps[ai][m] = s2;
                if (MODE == 0 && m == 3) asm volatile("" ::: "memory"); }
        if (MODE == 0) {
            ex2.run(ps, rs, u, wr, wc, fr, fq, lds);
#pragma unroll
            for (int bj = 0; bj < 2; ++bj)
#pragma unroll
                for (int n = 0; n < 2; ++n) wv[bj][n] = *(const f32x4*)(w2 + col0 + bj * HALF + 4 * n);
#pragma unroll
            for (int ai = 0; ai < 2; ++ai)
#pragma unroll
                for (int m = 0; m < 4; ++m) { const size_t ro = (size_t)(row0 + ai * HALF + m * 16) * 1024 + col0; const float r2 = rs[ai][m];
#pragma unroll
                    for (int bj = 0; bj < 2; ++bj) *(u32x4*)(XN2 + ro + bj * HALF) = pack8(acc[ai][bj][m][0] * r2 * wv[bj][0], acc[ai][bj][m][1] * r2 * wv[bj][1]); }
        }
    }
};

constexpr int EDGE_OFF = 131072;
__device__ __forceinline__ float dpp_shr1(float old, float src) { return __int_as_float(__builtin_amdgcn_update_dpp(__float_as_int(old), __float_as_int(src), 0x111, 0xF, 0xF, false)); }
__device__ __forceinline__ float dpp_shl1(float old, float src) { return __int_as_float(__builtin_amdgcn_update_dpp(__float_as_int(old), __float_as_int(src), 0x101, 0xF, 0xF, false)); }
__device__ __forceinline__ float dpp_ror1(float src) { return __int_as_float(__builtin_amdgcn_mov_dpp(__float_as_int(src), 0x121, 0xF, 0xF, false)); }
__device__ __forceinline__ float dpp_ror15(float src) { return __int_as_float(__builtin_amdgcn_mov_dpp(__float_as_int(src), 0x12F, 0xF, 0xF, false)); }
struct EpiConv {
    static constexpr bool PERM = true, AFTER_DRAIN = false, CHAIN = false;
    bf16_t* ACT; float* HALO; const float* cw; const float* cb;
    __device__ __forceinline__ void operator()(const f32x4 (&acc)[2][2][4][2], const Unit& u, int wr, int wc, int fr, int fq, PG8_LAS unsigned char* lds) const {
        PG8_LAS float* edge = (PG8_LAS float*)(lds + EDGE_OFF);
        const int lc0 = wc * 32 + 8 * fq;
#pragma unroll
        for (int ai = 0; ai < 2; ++ai)
#pragma unroll
            for (int bj = 0; bj < 2; ++bj)
#pragma unroll
                for (int n = 0; n < 2; ++n) { const int lc = bj * HALF + lc0 + 4 * n;
                    if (fr == 0) *(PG8_LAS f32x4*)(edge + ((ai * 2 + wr) * 2 + 0) * 256 + lc) = acc[ai][bj][0][n];
                    if (fr == 15) *(PG8_LAS f32x4*)(edge + ((ai * 2 + wr) * 2 + 1) * 256 + lc) = acc[ai][bj][3][n]; }
        { float* hp = HALO + (size_t)u.pm * 4 * 5632 + u.pn * 256;
          if (wr == 0 && fr < 2) {
#pragma unroll
            for (int bj = 0; bj < 2; ++bj)
#pragma unroll
                for (int n = 0; n < 2; ++n) *(f32x4*)(hp + (size_t)fr * 5632 + bj * HALF + lc0 + 4 * n) = acc[0][bj][0][n]; }
          if (wr == 1 && fr >= 14) {
#pragma unroll
            for (int bj = 0; bj < 2; ++bj)
#pragma unroll
                for (int n = 0; n < 2; ++n) *(f32x4*)(hp + (size_t)(fr - 12) * 5632 + bj * HALF + lc0 + 4 * n) = acc[1][bj][3][n]; } }
        asm volatile("s_waitcnt lgkmcnt(0)" ::: "memory"); __builtin_amdgcn_s_barrier(); asm volatile("" ::: "memory");
        const int row0 = u.pm * BM + wr * 64 + fr;
        unsigned keep[2][4][2];
#pragma unroll
        for (int n = 0; n < 2; ++n) {
            const int oc = u.pn * HALF + lc0 + 4 * n;
            f32x4 W[2][3], Bc[2];
#pragma unroll
            for (int bj = 0; bj < 2; ++bj) { Bc[bj] = *(const f32x4*)(cb + bj * 2816 + oc);
#pragma unroll
                for (int j = 0; j < 3; ++j) W[bj][j] = *(const f32x4*)(cw + (size_t)j * 5632 + bj * 2816 + oc); }
#pragma unroll
            for (int ai = 0; ai < 2; ++ai) {
                const int blk = ai * 2 + wr;
                f32x4 cv[2][4];
#pragma unroll
                for (int bj = 0; bj < 2; ++bj) { const int lc = bj * HALF + lc0 + 4 * n;
                    const f32x4 eup = blk > 0 ? *(const PG8_LAS f32x4*)(edge + ((blk - 1) * 2 + 1) * 256 + lc) : (f32x4){0.f, 0.f, 0.f, 0.f};
                    const f32x4 edn = blk < 3 ? *(const PG8_LAS f32x4*)(edge + ((blk + 1) * 2 + 0) * 256 + lc) : (f32x4){0.f, 0.f, 0.f, 0.f};
                    f32x4 T[4], S[4];
#pragma unroll
                    for (int m = 0; m < 4; ++m)
#pragma unroll
                        for (int i = 0; i < 4; ++i) { T[m][i] = dpp_ror1(acc[ai][bj][m][n][i]); S[m][i] = dpp_ror15(acc[ai][bj][m][n][i]); }
#pragma unroll
                    for (int m = 0; m < 4; ++m) { const f32x4 cur = acc[ai][bj][m][n]; const f32x4 tp = m > 0 ? T[m > 0 ? m - 1 : 0] : eup, sn = m < 3 ? S[m < 3 ? m + 1 : 3] : edn;
#pragma unroll
                        for (int i = 0; i < 4; ++i) { const float up = fr == 0 ? tp[i] : T[m][i], dn = fr == 15 ? sn[i] : S[m][i];
                            cv[bj][m][i] = W[bj][0][i] * up + W[bj][1][i] * cur[i] + W[bj][2][i] * dn + Bc[bj][i]; } } }
#pragma unroll
                for (int m = 0; m < 4; ++m) { typedef unsigned u32x2v __attribute__((ext_vector_type(2))); u32x2v w;
                    w.x = cvt_pk_bf16(gelu_tanh_f(cv[0][m][0]) * cv[1][m][0], gelu_tanh_f(cv[0][m][1]) * cv[1][m][1]);
                    w.y = cvt_pk_bf16(gelu_tanh_f(cv[0][m][2]) * cv[1][m][2], gelu_tanh_f(cv[0][m][3]) * cv[1][m][3]);
                    if (n == 0) { keep[ai][m][0] = w.x; keep[ai][m][1] = w.y; }
                    else { u32x4 w4; w4.x = keep[ai][m][0]; w4.y = keep[ai][m][1]; w4.z = w.x; w4.w = w.y; *(u32x4*)(ACT + (size_t)(row0 + ai * HALF + m * 16) * 2816 + oc - 4) = w4; } } } }
    }
};
template <class Epi, class Sched, bool ALIGN_EPI = true, bool SP2 = true>
__device__ __forceinline__ void gemm_phase(PG8_LAS unsigned char* lds, const Gemm g, const Sched& S, const Epi& E) {
    const int tid = threadIdx.x, wid = __builtin_amdgcn_readfirstlane(tid >> 6), lane = tid & 63, wr = wid >> 2, wc = wid & 3, fr = lane & 15, fq = lane >> 4;
    const int K = g.K, nt = K / BK;
    unsigned voffA[2], voffB[2];
#pragma unroll
    for (int i = 0; i < 2; ++i) { int R, C; stage_rc(tid * 16 + i * 8192, R, C); const int Rb = Epi::PERM ? ((R & ~31) + perm32(R & 31)) : R;
        voffA[i] = (unsigned)(R * g.lda + C) * 2u; voffB[i] = (unsigned)(Rb * g.ldb + C) * 2u; }
    const size_t kstep = (size_t)(BK * 2);
    const size_t hstepA = (size_t)HALF * g.lda * 2, hstepB = (size_t)HALF * g.ldb * 2;
    const size_t tstepA = 2 * hstepA, tstepB = 2 * hstepB;
    const unsigned ldsw = (unsigned)wid * 1024u;
    const int aoff = lds_byte(wr * 64 + fr, fq * 8), boff = lds_byte(wc * 32 + fr, fq * 8);
#define PG8_SA(b, h) (((b) * 2 + (h)) * HTB)
#define PG8_SB(b, h) ((4 + (b) * 2 + (h)) * HTB)
#define PG8_STAGE(bufoff, gbase, voff) do { _Pragma("unroll") for (int _i = 0; _i < 2; ++_i) \
        __builtin_amdgcn_global_load_lds((const unsigned*)((const char*)(gbase) + (voff)[_i]), (PG8_LAS unsigned*)(lds + (bufoff) + ldsw + _i * 8192), 16, 0, 0); } while (0)
#define PG8_LDA(dst, b, h) do { _Pragma("unroll") for (int m = 0; m < 4; ++m) _Pragma("unroll") for (int k = 0; k < 2; ++k) dst[m][k] = *(const PG8_LAS bf16x8*)(lds + PG8_SA(b, h) + aoff + m * 2048 + k * 1024); } while (0)
#define PG8_LDB(dst, b, h) do { _Pragma("unroll") for (int n = 0; n < 2; ++n) _Pragma("unroll") for (int k = 0; k < 2; ++k) dst[n][k] = *(const PG8_LAS bf16x8*)(lds + PG8_SB(b, h) + boff + n * 2048 + k * 1024); } while (0)
#define PG8_MMA(ai, bj, At, Bt) do { __builtin_amdgcn_s_setprio(1); _Pragma("unroll") for (int m = 0; m < 4; ++m) _Pragma("unroll") for (int n = 0; n < 2; ++n) _Pragma("unroll") for (int k = 0; k < 2; ++k) \
        acc[ai][bj][m][n] = __builtin_amdgcn_mfma_f32_16x16x32_bf16(Bt[n][k], At[m][k], acc[ai][bj][m][n], 0, 0, 0); __builtin_amdgcn_s_setprio(0); } while (0)
#define PG8_WAIT_V(n) asm volatile("s_waitcnt vmcnt(" #n ")" ::: "memory")
#define PG8_WAIT_L(n) asm volatile("s_waitcnt lgkmcnt(" #n ")" ::: "memory")
#define PG8_BAR __builtin_amdgcn_s_barrier()
#define PG8_SCHED __builtin_amdgcn_sched_barrier(0)
    Unit cur, nxt; int ui = 0;
    if (!S.next(0, cur)) return;
    f32x4 acc[2][2][4][2];
#pragma unroll
    for (int a = 0; a < 2; ++a)
#pragma unroll
        for (int b = 0; b < 2; ++b)
#pragma unroll
            for (int m = 0; m < 4; ++m)
#pragma unroll
                for (int n = 0; n < 2; ++n) acc[a][b][m][n] = (f32x4){0.f, 0.f, 0.f, 0.f};
    bf16x8 At[4][2], B0[2][2], B1[2][2];
    const char* cA = (const char*)g.A + (size_t)cur.pm * tstepA + cur.ko; const char* cB = (const char*)g.Bt + (size_t)cur.pn * tstepB + cur.ko;
    S.a_ready(cur);
    if constexpr (SP2) {
        PG8_STAGE(PG8_SB(0, 0), cB, voffB); PG8_STAGE(PG8_SB(0, 1), cB + hstepB, voffB); PG8_STAGE(PG8_SA(0, 0), cA, voffA); PG8_STAGE(PG8_SA(0, 1), cA + hstepA, voffA);
        if (wr == 1) PG8_BAR;
        PG8_WAIT_V(2); PG8_BAR;
        PG8_STAGE(PG8_SB(1, 0), cB + kstep, voffB); PG8_STAGE(PG8_SA(1, 0), cA + kstep, voffA); PG8_STAGE(PG8_SB(1, 1), cB + hstepB + kstep, voffB);
        PG8_WAIT_V(6); PG8_BAR;
    } else {
        PG8_STAGE(PG8_SB(0, 0), cB, voffB); PG8_STAGE(PG8_SA(0, 0), cA, voffA); PG8_STAGE(PG8_SB(0, 1), cB + hstepB, voffB); PG8_STAGE(PG8_SA(0, 1), cA + hstepA, voffA);
        if (wr == 1) PG8_BAR;
        PG8_WAIT_V(4); PG8_BAR;
        PG8_STAGE(PG8_SB(1, 0), cB + kstep, voffB); PG8_STAGE(PG8_SA(1, 0), cA + kstep, voffA); PG8_STAGE(PG8_SB(1, 1), cB + hstepB + kstep, voffB);
        PG8_WAIT_V(6); PG8_BAR;
    }
    for (;;) {
        const bool has_next = S.next(ui + 1, nxt);
        const char* nA = has_next ? (const char*)g.A + (size_t)nxt.pm * tstepA + nxt.ko : cA; const char* nB = has_next ? (const char*)g.Bt + (size_t)nxt.pn * tstepB + nxt.ko : cB;
        for (int t = 0; t < nt; t += 2) {
            const bool last = (t == nt - 2);
            const char* a1 = cA + (size_t)(t + 1) * kstep;
            const char* a2 = last ? nA : cA + (size_t)(t + 2) * kstep; const char* b2 = last ? nB : cB + (size_t)(t + 2) * kstep;
            const char* a3 = a2 + kstep; const char* b3 = b2 + kstep;
            if (last && has_next) S.a_ready(nxt);
            if constexpr (SP2) {
            PG8_LDB(B0, 0, 0); PG8_LDB(B1, 0, 1); PG8_SCHED; PG8_LDA(At, 0, 0); PG8_STAGE(PG8_SA(1, 1), a1 + hstepA, voffA);
            PG8_WAIT_V(8); PG8_WAIT_L(0); PG8_BAR; PG8_MMA(0, 0, At, B0); PG8_MMA(0, 1, At, B1); PG8_BAR; PG8_SCHED;
            PG8_LDA(At, 0, 1); PG8_STAGE(PG8_SB(0, 0), b2, voffB); PG8_STAGE(PG8_SB(0, 1), b2 + hstepB, voffB); PG8_STAGE(PG8_SA(0, 0), a2, voffA);
            PG8_WAIT_V(8); PG8_WAIT_L(0); PG8_BAR; PG8_MMA(1, 0, At, B0); PG8_MMA(1, 1, At, B1); PG8_BAR; PG8_SCHED;
            PG8_LDB(B0, 1, 0); PG8_LDB(B1, 1, 1); PG8_SCHED; PG8_LDA(At, 1, 0); PG8_STAGE(PG8_SA(0, 1), a2 + hstepA, voffA);
            PG8_WAIT_V(8); PG8_WAIT_L(0); PG8_BAR; PG8_MMA(0, 0, At, B0); PG8_MMA(0, 1, At, B1); PG8_BAR; PG8_SCHED;
            PG8_LDA(At, 1, 1); PG8_STAGE(PG8_SB(1, 0), b3, voffB); PG8_STAGE(PG8_SB(1, 1), b3 + hstepB, voffB); PG8_STAGE(PG8_SA(1, 0), a3, voffA);
            PG8_WAIT_V(8); PG8_WAIT_L(0); PG8_BAR; PG8_MMA(1, 0, At, B0); PG8_MMA(1, 1, At, B1); PG8_BAR; PG8_SCHED;
            } else {
            PG8_LDB(B0, 0, 0); PG8_SCHED; PG8_LDA(At, 0, 0); PG8_STAGE(PG8_SA(1, 1), a1 + hstepA, voffA);
            PG8_WAIT_L(8); PG8_BAR; PG8_WAIT_L(0); PG8_MMA(0, 0, At, B0); PG8_BAR; PG8_SCHED;
            PG8_LDB(B1, 0, 1); PG8_STAGE(PG8_SB(0, 0), b2, voffB);
            PG8_BAR; PG8_WAIT_L(0); PG8_MMA(0, 1, At, B1); PG8_BAR;
            PG8_LDA(At, 0, 1); PG8_STAGE(PG8_SA(0, 0), a2, voffA);
            PG8_BAR; PG8_WAIT_L(0); PG8_MMA(1, 0, At, B0); PG8_BAR; PG8_SCHED;
            PG8_STAGE(PG8_SB(0, 1), b2 + hstepB, voffB);
            PG8_WAIT_V(6); PG8_BAR; PG8_MMA(1, 1, At, B1); PG8_BAR;
            PG8_LDB(B0, 1, 0); PG8_SCHED; PG8_LDA(At, 1, 0); PG8_STAGE(PG8_SA(0, 1), a2 + hstepA, voffA);
            PG8_WAIT_L(8); PG8_BAR; PG8_WAIT_L(0); PG8_MMA(0, 0, At, B0); PG8_BAR; PG8_SCHED;
            PG8_LDB(B1, 1, 1); PG8_STAGE(PG8_SB(1, 0), b3, voffB);
            PG8_BAR; PG8_WAIT_L(0); PG8_MMA(0, 1, At, B1); PG8_BAR;
            PG8_LDA(At, 1, 1); PG8_STAGE(PG8_SA(1, 0), a3, voffA);
            PG8_BAR; PG8_WAIT_L(0); PG8_MMA(1, 0, At, B0); PG8_BAR; PG8_SCHED;
            PG8_STAGE(PG8_SB(1, 1), b3 + hstepB, voffB);
            PG8_WAIT_V(6); PG8_BAR; PG8_MMA(1, 1, At, B1); PG8_BAR;
            }
        }
        if constexpr (ALIGN_EPI) { if (wr == 0) PG8_BAR; }
        if constexpr (!Epi::AFTER_DRAIN) { E(acc, cur, wr, wc, fr, fq, lds); S.done(cur); }
        if (!has_next) break;
        if (!(Epi::CHAIN && cur.ko == 0))
#pragma unroll
        for (int a = 0; a < 2; ++a)
#pragma unroll
            for (int b = 0; b < 2; ++b)
#pragma unroll
                for (int m = 0; m < 4; ++m)
#pragma unroll
                    for (int n = 0; n < 2; ++n) acc[a][b][m][n] = (f32x4){0.f, 0.f, 0.f, 0.f};
        cur = nxt; cA = nA; cB = nB; ++ui;
        if constexpr (ALIGN_EPI) { if (wr == 1) PG8_BAR; }
    }
    PG8_WAIT_V(0);
    if constexpr (!ALIGN_EPI) { if (wr == 0) PG8_BAR; }
    PG8_BAR;
    if constexpr (Epi::AFTER_DRAIN) { E.fused(acc, cur, wr, wc, fr, fq, lds, wid, lane); S.done(cur); }
#undef PG8_SA
#undef PG8_SB
#undef PG8_STAGE
#undef PG8_LDA
#undef PG8_LDB
#undef PG8_MMA
#undef PG8_WAIT_V
#undef PG8_WAIT_L
#undef PG8_BAR
#undef PG8_SCHED
}
}
#include <hip/hip_bf16.h>
#include <cmath>
namespace attn_body {
using bf16=__hip_bfloat16;
using bf16x8=__attribute__((ext_vector_type(8)))short;
using s16x4=__attribute__((ext_vector_type(4)))short;
using f32x16=__attribute__((ext_vector_type(16)))float;
using u32x4=__attribute__((ext_vector_type(4)))unsigned;
constexpr int D=64,QP=512,KP=256,OP=1024;
constexpr int NW=8,QBLK=32,QB=QBLK*NW,KVBLK=64;
__device__ __forceinline__ int crow(int r,int hi){return (r&3)+8*(r>>2)+4*hi;}
#define SBAR() __builtin_amdgcn_sched_barrier(0)
__device__ __forceinline__ void cmask(f32x16&p0,f32x16&p1,int jb,int qrel,int hi){
  const float NEG=-INFINITY; int kb=64*jb+4*hi;
  #pragma unroll
  for(int r=0;r<16;++r){int kv=kb+(r&3)+8*(r>>2); if(kv>qrel)p0[r]=NEG; if(kv+32>qrel)p1[r]=NEG;}
}

constexpr int NSLOT=3, SLOTB=8192;
constexpr int LDS_K=0, LDS_V=NSLOT*SLOTB, LDS_WS=2*NSLOT*SLOTB, LDS_OST=LDS_WS+NW*64*4, LDS_BYTES=LDS_OST+NW*4096;
constexpr float C2=0.125f*1.4426950408889634f;
__device__ __forceinline__ void glds16(const void*gsrc,unsigned lds_dst){unsigned keep;
  asm volatile("s_mov_b32 %0, m0\n\ts_mov_b32 m0, %2\n\ts_nop 0\n\tglobal_load_lds_dwordx4 %1, off\n\ts_mov_b32 m0, %0":"=&s"(keep):"v"(gsrc),"s"(lds_dst):"memory");}
__device__ __forceinline__ float max3f(float a,float b,float c){float r;asm("v_max3_f32 %0, %1, %2, %3":"=v"(r):"v"(a),"v"(b),"v"(c));return r;}
__device__ __forceinline__ float max2f(float a,float b){float r;asm("v_max_f32_e32 %0, %1, %2":"=v"(r):"v"(a),"v"(b));return r;}
__device__ __forceinline__ float fadd_s(float a,float b){float r;asm("v_add_f32_e32 %0, %1, %2":"=v"(r):"v"(a),"v"(b));return r;}
__device__ __forceinline__ float fsub_s(float a,float b){float r;asm("v_sub_f32_e32 %0, %1, %2":"=v"(r):"v"(a),"v"(b));return r;}
typedef float f32x2_t __attribute__((ext_vector_type(2))); typedef __bf16 bf16x2_t __attribute__((ext_vector_type(2)));
__device__ __forceinline__ unsigned cvtpk_s(float lo,float hi){f32x2_t v={lo,hi};bf16x2_t b=__builtin_convertvector(v,bf16x2_t);return __builtin_bit_cast(unsigned,b);}
#define WAIT_BAR(N) asm volatile("s_waitcnt vmcnt(" #N ") lgkmcnt(0)\n\ts_barrier":::"memory")

__device__ __forceinline__ void qkt(f32x16&p0,f32x16&p1,const char*Kslot,const bf16x8*qr,const f32x16&negm,int r32,int hi){
  const char*kb=Kslot+hi*1024+r32*16;
  #pragma unroll
  for(int d0=0;d0<4;++d0){
    const bf16x8 b0=*reinterpret_cast<const bf16x8*>(kb+d0*2048);
    const bf16x8 b1=*reinterpret_cast<const bf16x8*>(kb+d0*2048+512);
    if(d0==0){p0=__builtin_amdgcn_mfma_f32_32x32x16_bf16(b0,qr[0],negm,0,0,0);p1=__builtin_amdgcn_mfma_f32_32x32x16_bf16(b1,qr[0],negm,0,0,0);}
    else{p0=__builtin_amdgcn_mfma_f32_32x32x16_bf16(b0,qr[d0],p0,0,0,0);p1=__builtin_amdgcn_mfma_f32_32x32x16_bf16(b1,qr[d0],p1,0,0,0);}}
}
typedef __attribute__((address_space(3))) const char* lds_cptr;
typedef short v4i16_t __attribute__((ext_vector_type(4)));
__device__ __forceinline__ void kload8(bf16x8*kf,lds_cptr kp){
  kf[0]=*(const __attribute__((address_space(3))) bf16x8*)(kp);      kf[1]=*(const __attribute__((address_space(3))) bf16x8*)(kp+512);
  kf[2]=*(const __attribute__((address_space(3))) bf16x8*)(kp+2048); kf[3]=*(const __attribute__((address_space(3))) bf16x8*)(kp+2560);
  kf[4]=*(const __attribute__((address_space(3))) bf16x8*)(kp+4096); kf[5]=*(const __attribute__((address_space(3))) bf16x8*)(kp+4608);
  kf[6]=*(const __attribute__((address_space(3))) bf16x8*)(kp+6144); kf[7]=*(const __attribute__((address_space(3))) bf16x8*)(kp+6656);
}
__device__ __forceinline__ void kload2(bf16x8*kf,lds_cptr kp,int j){ kf[2*j]=*(const __attribute__((address_space(3))) bf16x8*)(kp+j*2048); kf[2*j+1]=*(const __attribute__((address_space(3))) bf16x8*)(kp+j*2048+512); }
__device__ __forceinline__ s16x4 vtr(lds_cptr p){ return __builtin_bit_cast(s16x4,__builtin_amdgcn_ds_read_tr16_b64_v4i16((__attribute__((address_space(3))) v4i16_t*)p)); }
__device__ __forceinline__ float rowmax(const f32x16&p0,const f32x16&p1){
  float a=max3f(p0[0],p0[1],p1[0]),b=max3f(p0[2],p0[3],p1[1]);a=max3f(a,p1[2],p1[3]);
  #pragma unroll
  for(int r=4;r<16;r+=4){a=max3f(a,p0[r],p0[r+1]);b=max3f(b,p0[r+2],p0[r+3]);a=max3f(a,p1[r],p1[r+1]);b=max3f(b,p1[r+2],p1[r+3]);}
  const float m=max2f(a,b);
  auto rr=__builtin_amdgcn_permlane32_swap(__float_as_uint(m),__float_as_uint(m),false,false);
  return max2f(__uint_as_float(rr[0]),__uint_as_float(rr[1]));
}
__device__ __forceinline__ void pv(f32x16*o,int vb,bf16x8 pa0,bf16x8 pa1,bf16x8 pa2,bf16x8 pa3){
  #pragma unroll
  for(int d0=0;d0<2;++d0){s16x4 lo[4],hi[4];
    #pragma unroll
    for(int ks=0;ks<4;++ks){
      asm volatile("ds_read_b64_tr_b16 %0,%1 offset:%c2":"=&v"(lo[ks]):"v"(vb),"i"(d0*4096+ks*1024):"memory");
      asm volatile("ds_read_b64_tr_b16 %0,%1 offset:%c2":"=&v"(hi[ks]):"v"(vb),"i"(d0*4096+ks*1024+512):"memory");}
    asm volatile("s_waitcnt lgkmcnt(0)":::"memory");SBAR();
    #define PK(k) (bf16x8){lo[k][0],lo[k][1],lo[k][2],lo[k][3],hi[k][0],hi[k][1],hi[k][2],hi[k][3]}
    o[d0]=__builtin_amdgcn_mfma_f32_32x32x16_bf16(pa0,PK(0),o[d0],0,0,0);
    o[d0]=__builtin_amdgcn_mfma_f32_32x32x16_bf16(pa1,PK(1),o[d0],0,0,0);
    o[d0]=__builtin_amdgcn_mfma_f32_32x32x16_bf16(pa2,PK(2),o[d0],0,0,0);
    o[d0]=__builtin_amdgcn_mfma_f32_32x32x16_bf16(pa3,PK(3),o[d0],0,0,0);
    #undef PK
  }
}

#ifndef ATTN_STORE16
#define ATTN_STORE16(p,v) (*(u32x4*)(p)=(v))
#endif
template<int THRL> __device__ __forceinline__ void attn_unit(long rowbase,int NT,int h,int q0,const bf16*Q,const bf16*__restrict__ K,const bf16*__restrict__ V,bf16*O,char*shm){
  const int tid=threadIdx.x,lane=tid&63,r32=lane&31,hi=lane>>5; const int wid=__builtin_amdgcn_readfirstlane(tid>>6);
  const bf16*Qw=Q+(rowbase+q0+wid*QBLK)*QP+h*D;
  const bf16*Kh=K+rowbase*KP+(h>>2)*D,*Vh=V+rowbase*KP+(h>>2)*D;
  const unsigned lds0=(unsigned)(uintptr_t)shm;
  float*wsf=(float*)(shm+LDS_WS)+wid*64;
  const bf16*ksrc=Kh+(long)lane*KP+wid*8;
  const bf16*vsrc=Vh+(long)(16*(wid&3)+(lane>>2))*KP+(wid>>2)*32+(lane&3)*8;
  const unsigned kdst=lds0+LDS_K+wid*1024, vdst=lds0+LDS_V+wid*1024;
  #define DMA_K(t,slot) glds16(ksrc+(long)(t)*KVBLK*KP,(unsigned)__builtin_amdgcn_readfirstlane(kdst+(slot)))
  #define DMA_V(t,slot) glds16(vsrc+(long)(t)*KVBLK*KP,(unsigned)__builtin_amdgcn_readfirstlane(vdst+(slot)))
  const int vb0=(int)(lds0+LDS_V)+((lane>>4)&1)*32+(lane&3)*8+(4*hi+((lane&15)>>2))*64;
  const char*Kbase=shm+LDS_K; bf16x8 kf[8];
  const lds_cptr shm3=(lds_cptr)shm; const lds_cptr kp0=shm3+LDS_K+hi*1024+r32*16; const lds_cptr vp0=shm3+LDS_V+((lane>>4)&1)*32+(lane&3)*8+(4*hi+((lane&15)>>2))*64;
  DMA_K(0,0);DMA_V(0,0);DMA_K(1,SLOTB);
  bf16x8 qr[4];
  #pragma unroll
  for(int d0=0;d0<4;++d0)qr[d0]=*reinterpret_cast<const bf16x8*>(&Qw[(long)r32*QP+d0*16+hi*8]);
  float mhat=0.f,l_reg=0.f;f32x16 o[2];o[0]=f32x16{};o[1]=f32x16{};f32x16 negm=f32x16{};asm volatile("":"+v"(negm));
  #define CMASK(P0,P1,t) do{}while(0)
  bool resc=false;
  #define START(P0,P1) do{ const float rm=rowmax(P0,P1); resc=false; \
    { const float dl=rm; mhat=fadd_s(mhat,dl); \
      _Pragma("unroll") for(int r=0;r<16;++r){P0[r]=fsub_s(P0[r],dl);P1[r]=fsub_s(P1[r],dl);} \
      _Pragma("unroll") for(int r=0;r<16;++r)negm[r]=-mhat; asm volatile("":"+v"(negm)); } \
    _Pragma("unroll") for(int r=0;r<16;++r)P0[r]=__builtin_amdgcn_exp2f(P0[r]); }while(0)
  #define RESC() do{ if(resc){ asm volatile("s_waitcnt lgkmcnt(0)":::"memory"); \
      _Pragma("unroll") for(int d_=0;d_<2;++d_) _Pragma("unroll") for(int r=0;r<16;++r)o[d_][r]*=wsf[crow(r,hi)]; } }while(0)
  f32x16 pA0,pA1,pB0,pB1;
  int sl_prev=0,sl_cur=0,sl_next=SLOTB;
  #define ROT() do{sl_prev=sl_cur;sl_cur=sl_next;sl_next=(sl_next==(NSLOT-1)*SLOTB)?0:sl_next+SLOTB;}while(0)
  DMA_K(2,2*SLOTB);
  WAIT_BAR(3);
  qkt(pA0,pA1,Kbase,qr,negm,r32,hi);asm volatile("s_nop 15\n\ts_nop 7":"+v"(pA0),"+v"(pA1));CMASK(pA0,pA1,0);
  START(pA0,pA1);
  _Pragma("unroll") for(int r=0;r<16;++r)pA1[r]=__builtin_amdgcn_exp2f(pA1[r]);
  WAIT_BAR(0);
  DMA_K(3,0);DMA_V(1,SLOTB);
  ROT();
  kload8(kf,kp0+sl_cur);
  WAIT_BAR(2);
  s16x4 vlo[8],vhi[8]; u32x4 pw0,pw1,pw2,pw3;
  #define PKW(P,B) cvtpk_s(P[B],P[B+1])
  #define PAF(k) __builtin_bit_cast(bf16x8,pw##k)
  #define VFR(i) (bf16x8){vlo[i][0],vlo[i][1],vlo[i][2],vlo[i][3],vhi[i][0],vhi[i][1],vhi[i][2],vhi[i][3]}
  #define PIN(x) asm volatile("":"+v"(x))
  #define MX3(a,b,c) __builtin_fmaxf(__builtin_fmaxf((a),(b)),(c))
  #define GAPA(MF,A0,A1,A2,A3,W0,W1,PW) do{ MF; sacc+=A0; sacc+=A1; sacc+=A2; sacc+=A3; PIN(sacc); W0; W1; PIN(PW); SBAR(); }while(0)
  #define EX(v) __builtin_amdgcn_exp2f(v)
  #define GAPB(MF,X,B) do{ MF; X[B]=EX(X[B]); X[B+1]=EX(X[B+1]); X[B+2]=EX(X[B+2]); X[B+3]=EX(X[B+3]); PIN(X); SBAR(); }while(0)
  #define VRD(i) do{ vlo[i]=vtr(vp_+(((i)>>2)*4096+((i)&3)*1024)); vhi[i]=vtr(vp_+(((i)>>2)*4096+((i)&3)*1024+512)); }while(0)
  #define KRD(G,j) do{ if(G){ kload2(kf,kp0+sl_next,j); SBAR(); } }while(0)
  #define STEP(C0,C1,P0,P1,t,GK,GV,GL) do{ SBAR(); \
    const lds_cptr vp_=vp0+sl_prev; \
    VRD(0); SBAR(); float sacc=(P0[0]+P0[1]); \
    GAPA(C0=__builtin_amdgcn_mfma_f32_32x32x16_bf16(kf[0],qr[0],negm,0,0,0), P0[2],P0[3],P0[4],P0[5],     pw0[0]=PKW(P0,0), pw0[1]=PKW(P0,2), pw0); \
    VRD(4); SBAR(); GAPA(C1=__builtin_amdgcn_mfma_f32_32x32x16_bf16(kf[1],qr[0],negm,0,0,0), P0[6],P0[7],P0[8],P0[9],     pw0[2]=PKW(P0,4), pw0[3]=PKW(P0,6), pw0); \
    VRD(1); SBAR(); GAPA(C0=__builtin_amdgcn_mfma_f32_32x32x16_bf16(kf[2],qr[1],C0,0,0,0),   P0[10],P0[11],P0[12],P0[13], pw1[0]=PKW(P0,8), pw1[1]=PKW(P0,10), pw1); \
    VRD(5); SBAR(); GAPA(C1=__builtin_amdgcn_mfma_f32_32x32x16_bf16(kf[3],qr[1],C1,0,0,0),   P0[14],P0[15],P1[0],P1[1],   pw1[2]=PKW(P0,12),pw1[3]=PKW(P0,14), pw1); \
    VRD(2); SBAR(); GAPA(C0=__builtin_amdgcn_mfma_f32_32x32x16_bf16(kf[4],qr[2],C0,0,0,0),   P1[2],P1[3],P1[4],P1[5],     pw2[0]=PKW(P1,0), pw2[1]=PKW(P1,2), pw2); \
    VRD(6); SBAR(); GAPA(C1=__builtin_amdgcn_mfma_f32_32x32x16_bf16(kf[5],qr[2],C1,0,0,0),   P1[6],P1[7],P1[8],P1[9],     pw2[2]=PKW(P1,4), pw2[3]=PKW(P1,6), pw2); \
    VRD(3); SBAR(); GAPA(C0=__builtin_amdgcn_mfma_f32_32x32x16_bf16(kf[6],qr[3],C0,0,0,0),   P1[10],P1[11],P1[12],P1[13], pw3[0]=PKW(P1,8), pw3[1]=PKW(P1,10), pw3); \
    VRD(7); SBAR(); GAPA(C1=__builtin_amdgcn_mfma_f32_32x32x16_bf16(kf[7],qr[3],C1,0,0,0),   P1[14],P1[15],0.f,0.f,       pw3[2]=PKW(P1,12),pw3[3]=PKW(P1,14), pw3); \
    l_reg+=sacc; \
    if(GK){DMA_K((t)+3,sl_cur);} if(GV){DMA_V((t)+1,sl_next);} \
    CMASK(C0,C1,t); \
    { float a=MX3(C0[0],C0[1],C1[0]),b=MX3(C0[2],C0[3],C1[1]); a=MX3(a,C1[2],C1[3]); \
      _Pragma("unroll") for(int r=4;r<16;r+=4){a=MX3(a,C0[r],C0[r+1]);b=MX3(b,C0[r+2],C0[r+3]);a=MX3(a,C1[r],C1[r+1]);b=MX3(b,C1[r+2],C1[r+3]);} \
      float rm=__builtin_fmaxf(a,b); { auto rr=__builtin_amdgcn_permlane32_swap(__float_as_uint(rm),__float_as_uint(rm),false,false); rm=__builtin_fmaxf(__uint_as_float(rr[0]),__uint_as_float(rr[1])); } \
      resc=false; \
      if(__builtin_expect(__any(rm>(float)THRL),0)){ const float dl=__builtin_fmaxf(rm,0.f); mhat+=dl; \
        _Pragma("unroll") for(int r=0;r<16;++r){C0[r]-=dl;C1[r]-=dl;} \
        _Pragma("unroll") for(int r=0;r<16;++r)negm[r]=-mhat; asm volatile("":"+v"(negm)); \
        const float f=__builtin_amdgcn_exp2f(-dl); l_reg*=f; if(hi==0)wsf[r32]=f; resc=true; } } \
    SBAR(); \
    GAPB(o[0]=__builtin_amdgcn_mfma_f32_32x32x16_bf16(PAF(0),VFR(0),o[0],0,0,0), C0,0); \
    GAPB(o[1]=__builtin_amdgcn_mfma_f32_32x32x16_bf16(PAF(0),VFR(4),o[1],0,0,0), C0,4); \
    KRD(GL,0); GAPB(o[0]=__builtin_amdgcn_mfma_f32_32x32x16_bf16(PAF(1),VFR(1),o[0],0,0,0), C0,8); \
    KRD(GL,1); GAPB(o[1]=__builtin_amdgcn_mfma_f32_32x32x16_bf16(PAF(1),VFR(5),o[1],0,0,0), C0,12); \
    KRD(GL,2); GAPB(o[0]=__builtin_amdgcn_mfma_f32_32x32x16_bf16(PAF(2),VFR(2),o[0],0,0,0), C1,0); \
    KRD(GL,3); GAPB(o[1]=__builtin_amdgcn_mfma_f32_32x32x16_bf16(PAF(2),VFR(6),o[1],0,0,0), C1,4); \
    GAPB(o[0]=__builtin_amdgcn_mfma_f32_32x32x16_bf16(PAF(3),VFR(3),o[0],0,0,0), C1,8); \
    GAPB(o[1]=__builtin_amdgcn_mfma_f32_32x32x16_bf16(PAF(3),VFR(7),o[1],0,0,0), C1,12); \
    }while(0)
  int t=1;
  #undef CMASK
  #define CMASK(P0,P1,t) do{}while(0)
  for(;t+5<NT;t+=2){
    STEP(pB0,pB1,pA0,pA1,t,true,true,true);     WAIT_BAR(2); RESC(); ROT();
    STEP(pA0,pA1,pB0,pB1,t+1,true,true,true);   WAIT_BAR(2); RESC(); ROT();
  }
  #undef CMASK
  #define CMASK(P0,P1,t) do{}while(0)
  #define ENDW(tt) do{ if((tt)+3<NT){WAIT_BAR(2);} else if((tt)+2<NT){WAIT_BAR(1);} else {WAIT_BAR(0);} }while(0)
  for(;t+1<NT;t+=2){
    STEP(pB0,pB1,pA0,pA1,t,(t+3<NT),(t+1<NT),(t+1<NT));       ENDW(t);   RESC(); ROT();
    STEP(pA0,pA1,pB0,pB1,t+1,(t+4<NT),(t+2<NT),(t+2<NT));     ENDW(t+1); RESC(); ROT();
  }
  STEP(pB0,pB1,pA0,pA1,NT-1,false,false,false); RESC();
  { float sacc=pB0[0]+pB0[1]; _Pragma("unroll") for(int r=2;r<16;++r)sacc+=pB0[r]; _Pragma("unroll") for(int r=0;r<16;++r)sacc+=pB1[r]; l_reg+=sacc;
    pw0=(u32x4){PKW(pB0,0),PKW(pB0,2),PKW(pB0,4),PKW(pB0,6)};pw1=(u32x4){PKW(pB0,8),PKW(pB0,10),PKW(pB0,12),PKW(pB0,14)};pw2=(u32x4){PKW(pB1,0),PKW(pB1,2),PKW(pB1,4),PKW(pB1,6)};pw3=(u32x4){PKW(pB1,8),PKW(pB1,10),PKW(pB1,12),PKW(pB1,14)};
    SBAR(); pv(o,vb0+sl_cur,PAF(0),PAF(1),PAF(2),PAF(3)); }
  #undef PKW
  #undef PAF
  #undef VFR
  #undef PIN
  #undef MX3
  #undef GAPA
  #undef GAPB
  #undef EX
  #undef VRD
  #undef KRD
  #undef STEP
  #undef ENDW
  {auto rr=__builtin_amdgcn_permlane32_swap(__float_as_uint(l_reg),__float_as_uint(l_reg),false,false);l_reg=__uint_as_float(rr[0])+__uint_as_float(rr[1]);}
  if(hi==0)wsf[32+r32]=l_reg;asm volatile("s_waitcnt lgkmcnt(0)":::"memory");
  float rli[16];
  #pragma unroll
  for(int r=0;r<16;++r)rli[r]=__builtin_amdgcn_rcpf(wsf[32+crow(r,hi)]);
  bf16*Ow=O+(rowbase+q0+wid*QBLK)*OP+h*D;
  { bf16*stg=(bf16*)(shm+LDS_OST)+wid*2048;
    #pragma unroll
    for(int r=0;r<16;++r){const int orow=crow(r,hi);
      #pragma unroll
      for(int d0=0;d0<2;++d0)stg[orow*64+d0*32+r32]=__float2bfloat16(o[d0][r]*rli[r]);}
    asm volatile("s_waitcnt lgkmcnt(0)":::"memory");
    #pragma unroll
    for(int i=0;i<4;++i){const int row=i*8+(lane>>3),ch=lane&7; const u32x4 v=*(const u32x4*)(stg+row*64+ch*8); ATTN_STORE16(Ow+(long)row*OP+ch*8,v);} }
  asm volatile("s_waitcnt lgkmcnt(0)\n\ts_barrier":::"memory");
  #undef DMA_K
  #undef DMA_V
  #undef CMASK
  #undef START
  #undef RESC
  #undef ROT
}
constexpr int ATTN_LDS_BYTES=LDS_BYTES;
#undef SBAR
#undef WAIT_BAR
}
namespace nat {
#define NLAS __attribute__((address_space(3)))
typedef short bf16x8 __attribute__((ext_vector_type(8)));
typedef short s16x4 __attribute__((ext_vector_type(4)));
typedef float f32x4 __attribute__((ext_vector_type(4)));
typedef unsigned u32x4 __attribute__((ext_vector_type(4)));
typedef unsigned u32x2 __attribute__((ext_vector_type(2)));
typedef unsigned short bf16_t;
constexpr int VOFF = 73728, RPB_OFF = 147456;
__device__ __forceinline__ s16x4 vtr(const NLAS unsigned char* p) { return __builtin_bit_cast(s16x4, __builtin_amdgcn_ds_read_tr16_b64_v4i16((NLAS s16x4*)p)); }
__device__ __forceinline__ unsigned cvtpk(float lo, float hi) { unsigned r; asm volatile("v_cvt_pk_bf16_f32 %0, %1, %2" : "=v"(r) : "v"(lo), "v"(hi)); return r; }
__device__ __forceinline__ int swz(int key, int chunk) { return key * 128 + ((chunk ^ ((key >> 1) & 7)) << 4); }
__device__ __forceinline__ int clampi(int v, int lo, int hi) { return v < lo ? lo : (v > hi ? hi : v); }

__device__ __forceinline__ void step(const bf16x8 bq0, const bf16x8 bq1, bf16_t* __restrict__ OAB, const NLAS float* rp, const NLAS unsigned char* L, long row0, int ra, int rsa, int rsb, int lo, int nb, int h, int wave, int lane) {
    const int n = lane & 15, g = lane >> 4, qc = 8 * wave + (n & 7);
    const int kc0 = clampi(8 * wave - 8, 0, 32);
    const int myr = ra + (n >> 3), myrs = (n < 8) ? rsa : rsb;
    const int cs = clampi(qc - 8, 0, 48);
    int ci[2][4];
#pragma unroll
    for (int kt = 0; kt < 2; ++kt)
#pragma unroll
        for (int i = 0; i < 4; ++i) { const int kc = kc0 + 16 * kt + 4 * g + i; ci[kt][i] = (kc >= cs && kc < cs + 16) ? clampi(kc - qc + 15, 0, 30) : 31; }
    f32x4 s[9][2];
#pragma unroll
    for (int bi = 0; bi < 9; ++bi) {
        if (bi < 8 || nb == 9) { const int br = lo + bi; const NLAS unsigned char* ks = L + (br % 9) * 8192;
            const bool inw = (br >= myrs) && (br <= myrs + 7); const int rofs = inw ? (br - myr + 7) * 32 : 15 * 32;
#pragma unroll
            for (int kt = 0; kt < 2; ++kt) { const int key = kc0 + 16 * kt + n;
                const bf16x8 a0 = *(const NLAS bf16x8*)(ks + swz(key, g)), a1 = *(const NLAS bf16x8*)(ks + swz(key, 4 + g));
                f32x4 c;
#pragma unroll
                for (int i = 0; i < 4; ++i) c[i] = rp[rofs + ci[kt][i]];
                c = __builtin_amdgcn_mfma_f32_16x16x32_bf16(a0, bq0, c, 0, 0, 0); c = __builtin_amdgcn_mfma_f32_16x16x32_bf16(a1, bq1, c, 0, 0, 0);
                s[bi][kt] = c; }
        } else { s[bi][0] = (f32x4){-INFINITY, -INFINITY, -INFINITY, -INFINITY}; s[bi][1] = s[bi][0]; }
    }
    float mx = -INFINITY;
#pragma unroll
    for (int bi = 0; bi < 9; ++bi)
#pragma unroll
        for (int kt = 0; kt < 2; ++kt)
#pragma unroll
            for (int i = 0; i < 4; ++i) mx = fmaxf(mx, s[bi][kt][i]);
    mx = fmaxf(mx, __shfl_xor(mx, 16)); mx = fmaxf(mx, __shfl_xor(mx, 32));
    float sum = 0.f;
#pragma unroll
    for (int bi = 0; bi < 9; ++bi)
#pragma unroll
        for (int kt = 0; kt < 2; ++kt)
#pragma unroll
            for (int i = 0; i < 4; ++i) { const float p = __builtin_amdgcn_exp2f(s[bi][kt][i] - mx); s[bi][kt][i] = p; sum += p; }
    sum += __shfl_xor(sum, 16); sum += __shfl_xor(sum, 32);
    const float inv = 1.0f / sum;
    f32x4 o[4];
#pragma unroll
    for (int dt = 0; dt < 4; ++dt) o[dt] = (f32x4){0.f, 0.f, 0.f, 0.f};
    const int qq = (lane & 15) >> 2, pp = lane & 3;
#pragma unroll
    for (int bi = 0; bi < 9; ++bi) {
        if (bi < 8 || nb == 9) { const NLAS unsigned char* vs = L + VOFF + ((lo + bi) % 9) * 8192;
            u32x4 pw; pw.x = cvtpk(s[bi][0][0], s[bi][0][1]); pw.y = cvtpk(s[bi][0][2], s[bi][0][3]); pw.z = cvtpk(s[bi][1][0], s[bi][1][1]); pw.w = cvtpk(s[bi][1][2], s[bi][1][3]);
            const bf16x8 pb = __builtin_bit_cast(bf16x8, pw);
            const int k0 = kc0 + 4 * g + qq, k1 = k0 + 16;
            s16x4 vlo[4], vhi[4];
#pragma unroll
            for (int dt = 0; dt < 4; ++dt) { vlo[dt] = vtr(vs + swz(k0, 2 * dt + (pp >> 1)) + 8 * (pp & 1)); vhi[dt] = vtr(vs + swz(k1, 2 * dt + (pp >> 1)) + 8 * (pp & 1)); }
#pragma unroll
            for (int dt = 0; dt < 4; ++dt) { const bf16x8 a = (bf16x8){vlo[dt][0], vlo[dt][1], vlo[dt][2], vlo[dt][3], vhi[dt][0], vhi[dt][1], vhi[dt][2], vhi[dt][3]};
                o[dt] = __builtin_amdgcn_mfma_f32_16x16x32_bf16(a, pb, o[dt], 0, 0, 0); } }
    }
    bf16_t* op = OAB + (size_t)(row0 + myr * 64 + qc) * 1024 + 512 + h * 64 + 4 * g;
#pragma unroll
    for (int dt = 0; dt < 4; ++dt) { u32x2 w2; w2.x = cvtpk(o[dt][0] * inv, o[dt][1] * inv); w2.y = cvtpk(o[dt][2] * inv, o[dt][3] * inv); *(u32x2*)(op + 16 * dt) = w2; }
}
__device__ __forceinline__ void unit(const bf16_t* __restrict__ QB, const bf16_t* __restrict__ KB, const bf16_t* __restrict__ VB, bf16_t* __restrict__ OAB, const float* __restrict__ rpb,
                                     NLAS unsigned char* L, int id, int tid, int wave, int lane) {
    long row0; int h, r0, nrows;
    if (id < 1024) { const int pair = id >> 2; row0 = (long)(pair >> 3) * 2048; h = pair & 7; r0 = (id & 3) * 8; nrows = 32; }
    else { const int t = id - 1024; const int pair = t >> 4; row0 = 65536 + (long)(pair >> 3) * 8192; h = pair & 7; r0 = (t & 15) * 8; nrows = 128; }
    NLAS float* rl = (NLAS float*)(L + RPB_OFF);
    if (tid < 512) rl[tid] = ((tid & 31) < 31 && tid < 480) ? rpb[h * 465 + (tid >> 5) * 31 + (tid & 31)] * 1.4426950408889634f : -INFINITY;
    const int key = tid >> 3, chunk = tid & 7; const int so = swz(key, chunk);
    const bf16_t* kg = KB + (size_t)(row0 + key) * 512 + h * 64 + chunk * 8; const bf16_t* vg = VB + (size_t)(row0 + key) * 512 + h * 64 + chunk * 8;
    int rsa = clampi(r0 - 4, 0, nrows - 8), rsb = clampi(r0 + 1 - 4, 0, nrows - 8);
    int lo = rsa, hi = rsb + 7;
    { u32x4 kk[9], vv[9];
#pragma unroll
      for (int w = 0; w < 9; ++w) if (lo + w <= hi) { const size_t off = (size_t)(lo + w) * 64 * 512; kk[w] = *(const u32x4*)(kg + off); vv[w] = *(const u32x4*)(vg + off); }
#pragma unroll
      for (int w = 0; w < 9; ++w) if (lo + w <= hi) { const int sl = ((lo + w) % 9) * 8192; *(NLAS u32x4*)(L + sl + so) = kk[w]; *(NLAS u32x4*)(L + VOFF + sl + so) = vv[w]; } }
    const bf16_t* qg = QB + (size_t)(row0 + 8 * wave + (lane & 7)) * 512 + h * 64 + 8 * (lane >> 4);
    const int qsel = (lane >> 3) & 1;
    bf16x8 q0 = *(const bf16x8*)(qg + (size_t)(r0 + qsel) * 64 * 512), q1 = *(const bf16x8*)(qg + (size_t)(r0 + qsel) * 64 * 512 + 32);
    __syncthreads();
    for (int ra = r0; ra < r0 + 8; ra += 2) {
        const bool more = ra + 2 < r0 + 8;
        const int rsa2 = more ? clampi(ra + 2 - 4, 0, nrows - 8) : rsa, rsb2 = more ? clampi(ra + 3 - 4, 0, nrows - 8) : rsb;
        const int hi2 = rsb2 + 7; const int nnew = hi2 - hi;
        u32x4 kn[2], vn[2]; bf16x8 qn0 = q0, qn1 = q1;
#pragma unroll
        for (int k = 0; k < 2; ++k) { kn[k] = (u32x4){0u, 0u, 0u, 0u}; vn[k] = kn[k]; if (k < nnew) { const size_t off = (size_t)(hi + 1 + k) * 64 * 512; kn[k] = *(const u32x4*)(kg + off); vn[k] = *(const u32x4*)(vg + off); } }
        if (more) { qn0 = *(const bf16x8*)(qg + (size_t)(ra + 2 + qsel) * 64 * 512); qn1 = *(const bf16x8*)(qg + (size_t)(ra + 2 + qsel) * 64 * 512 + 32); }
        step(q0, q1, OAB, rl, L, row0, ra, rsa, rsb, lo, hi - lo + 1, h, wave, lane);
        asm volatile("s_waitcnt lgkmcnt(0)" ::: "memory"); __builtin_amdgcn_s_barrier(); asm volatile("" ::: "memory");
        if (nnew > 0) {
#pragma unroll
            for (int k = 0; k < 2; ++k) if (k < nnew) { const int sl = ((hi + 1 + k) % 9) * 8192; *(NLAS u32x4*)(L + sl + so) = kn[k]; *(NLAS u32x4*)(L + VOFF + sl + so) = vn[k]; }
            asm volatile("s_waitcnt lgkmcnt(0)" ::: "memory"); __builtin_amdgcn_s_barrier(); asm volatile("" ::: "memory"); }
        rsa = rsa2; rsb = rsb2; lo = rsa2; hi = hi2; q0 = qn0; q1 = qn1;
    }
}
#undef NLAS
}
constexpr int NWAVES = 8;
constexpr int M = 81920, MP = 65536, DMODEL = 1024, DIN = 4352, DFF = 2816, DUP = 5632;
constexpr float EPS = 1e-6f;
constexpr size_t MiB = 1u << 20;
constexpr size_t WS_TAB = 1 * MiB, WS_WIN = 2 * MiB, WS_WCAT = 11 * MiB, WS_WOUT = 13 * MiB, WS_WUP = 15 * MiB, WS_WDN = 26 * MiB;
constexpr size_t WS_SS1 = 32 * MiB, WS_SS2 = 37 * MiB, WS_HALO = 42 * MiB;
constexpr size_t WS_XN = 72 * MiB;
constexpr size_t WS_QA = 232 * MiB, WS_KVA = 312 * MiB, WS_QB = 352 * MiB, WS_KB = 432 * MiB, WS_VB = 512 * MiB, WS_GATE = 592 * MiB;
constexpr size_t WS_G = 432 * MiB;
constexpr size_t WS_MIX = 232 * MiB;
constexpr size_t WS_ACT = 432 * MiB;
constexpr size_t WS_END = 912 * MiB;
static_assert(WS_HALO + (size_t)320 * 4 * 5632 * 4 <= WS_XN && WS_ACT + (size_t)M * DFF * 2 <= WS_END && WS_GATE + (size_t)M * 2048 * 2 <= WS_END, "d_ws map");
constexpr int RING_BYTES = 131072, LDS_BYTES = 163840;

#define GAS __attribute__((address_space(1)))
#define LAS __attribute__((address_space(3)))
typedef unsigned short bf16;
typedef unsigned v4u __attribute__((ext_vector_type(4)));
typedef unsigned v2u __attribute__((ext_vector_type(2)));
typedef float f32x4 __attribute__((ext_vector_type(4)));
#define LDS_WAIT() asm volatile("s_waitcnt lgkmcnt(0)" ::: "memory")
__device__ __forceinline__ unsigned pk2(float lo, float hi) { return pg8::cvt_pk_bf16(lo, hi); }
__device__ __forceinline__ float wave_sum(float v) {
#pragma unroll
    for (int o = 1; o < 64; o <<= 1) v += __shfl_xor(v, o);
    return v;
}
__device__ __forceinline__ void p0_transpose_item(const float* W, int N, bf16* WT, int ldk, int koff, int drow0, LAS float* scr, int k0, int n0, int lane) {
#pragma unroll 8
    for (int i = 0; i < 32; ++i) { const int kk = 2 * i + (lane >> 5); scr[kk * 33 + (lane & 31)] = W[(size_t)(k0 + kk) * N + n0 + (lane & 31)]; }
    LDS_WAIT(); asm volatile("" ::: "memory");
    const int c = lane & 7;
#pragma unroll
    for (int j = 0; j < 4; ++j) { const int n = (lane >> 3) + 8 * j; const LAS float* s = scr + (8 * c) * 33 + n;
        v4u o; o.x = pk2(s[0 * 33], s[1 * 33]); o.y = pk2(s[2 * 33], s[3 * 33]); o.z = pk2(s[4 * 33], s[5 * 33]); o.w = pk2(s[6 * 33], s[7 * 33]);
        *(v4u*)(WT + (size_t)(drow0 + n) * ldk + koff + k0 + 8 * c) = o; }
    LDS_WAIT(); asm volatile("" ::: "memory");
}
__device__ __forceinline__ void sincos_d(double x, double& s, double& c) {
    const double k = rint(x * 0.15915494309189533577); const double r = x - k * 6.283185307179586476925; const double r2 = r * r;
    double ts = r, tc = 1.0; s = r; c = 1.0;
#pragma unroll 1
    for (int n = 1; n <= 15; ++n) { ts = -ts * r2 / (double)((2 * n) * (2 * n + 1)); tc = -tc * r2 / (double)((2 * n - 1) * (2 * n)); s += ts; c += tc; }
}
__device__ __forceinline__ const float* xrow(const float* xp, const float* xs, int m) { return m < MP ? xp + (size_t)m * DMODEL : xs + (size_t)(m - MP) * DMODEL; }

#define XB_TMO      128
#define XB_XCNT(j)  (256  + 64 * (j))
#define XB_XSUB(j)  (1280 + 64 * (j))
#define XB_XGEN(j)  (2304 + 64 * (j))
#define XB_TOP      3328
#define XB_TOPGEN   3392
#define XCD_BAR_WORDS 3456
#define XB_SPIN_CAP (1u << 18)

__device__ __forceinline__ unsigned xb_ld(unsigned* p)              { return __hip_atomic_load(p, __ATOMIC_RELAXED, __HIP_MEMORY_SCOPE_AGENT); }
__device__ __forceinline__ unsigned xb_add(unsigned* p, unsigned v) { return __hip_atomic_fetch_add(p, v, __ATOMIC_RELAXED, __HIP_MEMORY_SCOPE_AGENT); }
__device__ __forceinline__ unsigned xb_xcc_id() { return (unsigned)__builtin_amdgcn_s_getreg((3 << 11) | 20) & 0xFu; }
#define XB_SPIN(cond, bar) do { unsigned _sp = 0; while (cond) { __builtin_amdgcn_s_sleep(1); \
    if ((++_sp & 255u) == 0u) { if (xb_ld(&(bar)[XB_TMO])) break; if (_sp > XB_SPIN_CAP) { atomicAdd(&(bar)[XB_TMO], 1u); break; } } } } while (0)

struct XcdBarrier {
    unsigned* bar; unsigned x;
    volatile LAS unsigned* st;
};

__device__ __forceinline__ XcdBarrier xcd_barrier_post(unsigned* bar, volatile LAS unsigned* st) {
    XcdBarrier b; b.bar = bar; b.x = xb_xcc_id(); b.st = st;
    if (threadIdx.x == 0) (void)xb_add(&bar[XB_XCNT(b.x)], 1u);
    return b;
}
__device__ __forceinline__ void xcd_barrier_complete(unsigned* bar, unsigned x, unsigned& nloc, unsigned& nx) {
    const unsigned G = gridDim.x * gridDim.y * gridDim.z;
    unsigned sum, cnt, mine, sp = 0u;
    for (;;) {
        sum = 0u; cnt = 0u; mine = 0u;
#pragma unroll
        for (unsigned j = 0; j < 16; ++j) { const unsigned c = xb_ld(&bar[XB_XCNT(j)]); sum += c; cnt += (c > 0u) ? 1u : 0u; mine = (j == x) ? c : mine; }
        if (sum == G) break;
        __builtin_amdgcn_s_sleep(1);
        if ((++sp & 255u) == 0u) { if (xb_ld(&bar[XB_TMO])) break; if (sp > XB_SPIN_CAP) { atomicAdd(&bar[XB_TMO], 1u); break; } }
    }
    nloc = mine > 0u ? mine : 1u; nx = cnt > 0u ? cnt : 1u;
}

__device__ __forceinline__ void xcd_barrier(const XcdBarrier& b) {
    asm volatile("s_waitcnt vmcnt(0)" ::: "memory");
    __syncthreads();
    if (threadIdx.x == 0) {
        unsigned* bar = b.bar;
        __builtin_amdgcn_s_waitcnt(0);
        unsigned nloc = b.st[0], nx = b.st[1];
        if (nloc == 0u) { xcd_barrier_complete(bar, b.x, nloc, nx); b.st[0] = nloc; b.st[1] = nx; }
        const unsigned old = xb_add(&bar[XB_XSUB(b.x)], 1u);
        const unsigned gen = old / nloc;
        if (old + 1u == (gen + 1u) * nloc) {
            __builtin_amdgcn_fence(__ATOMIC_RELEASE, "agent");
            asm volatile("s_waitcnt vmcnt(0)" ::: "memory");
            const unsigned og = xb_add(&bar[XB_TOP], 1u);
            const unsigned tg = og / nx;
            if (og + 1u == (tg + 1u) * nx) xb_add(&bar[XB_TOPGEN], 1u);
            else XB_SPIN(xb_ld(&bar[XB_TOPGEN]) == tg, bar);
            __builtin_amdgcn_fence(__ATOMIC_ACQUIRE, "agent");
            xb_add(&bar[XB_XGEN(b.x)], 1u);
            asm volatile("s_waitcnt vmcnt(0)" ::: "memory");
        } else {
            XB_SPIN(xb_ld(&bar[XB_XGEN(b.x)]) == gen, bar);
            __builtin_amdgcn_fence(__ATOMIC_ACQUIRE, "agent");
            asm volatile("s_waitcnt vmcnt(0)" ::: "memory");
        }
    }
    __syncthreads();
}

struct Args { const float* in[18]; float* out; unsigned char* ws; int ph_lo, ph_hi; };
enum { I_XP = 0, I_XS, I_PREMIX, I_WIN, I_BGATE, I_QN, I_KN, I_RPB, I_WPA, I_WPB, I_WOUT, I_POSTMIX, I_PREFFN, I_WUP, I_CW, I_CB, I_WDN, I_POSTFFN };
constexpr int NPHASE = 11;

__global__ void __launch_bounds__(NWAVES * 64, 2) enc_fwd(Args args) {
    extern __shared__ __attribute__((aligned(16))) unsigned char lds[];
    cg::grid_group grid = cg::this_grid();
    const int tid = threadIdx.x, lane = tid & 63, wave = __builtin_amdgcn_readfirstlane(tid >> 6);
    const int G = gridDim.x; const int bx = blockIdx.x; const int vcu = (G % 8 == 0) ? (bx % 8) * (G / 8) + bx / 8 : bx;
    const int gw = vcu * NWAVES + wave, NGW = G * NWAVES;
    unsigned char* ws = args.ws;
    LAS unsigned char* L = (LAS unsigned char*)lds;
    const float* xp = args.in[I_XP]; const float* xs = args.in[I_XS];
    bf16* Win_t = (bf16*)(ws + WS_WIN); bf16* Wcat_t = (bf16*)(ws + WS_WCAT); bf16* Wout_t = (bf16*)(ws + WS_WOUT); bf16* Wup_t = (bf16*)(ws + WS_WUP); bf16* Wdn_t = (bf16*)(ws + WS_WDN);
    float* TAB = (float*)(ws + WS_TAB); float* SS1 = (float*)(ws + WS_SS1); float* SS2 = (float*)(ws + WS_SS2); float* HALO = (float*)(ws + WS_HALO);
    bf16* XN = (bf16*)(ws + WS_XN); bf16* QA = (bf16*)(ws + WS_QA); bf16* KVA = (bf16*)(ws + WS_KVA); bf16* QB = (bf16*)(ws + WS_QB); bf16* KB = (bf16*)(ws + WS_KB); bf16* VB = (bf16*)(ws + WS_VB);
    bf16* GATE = (bf16*)(ws + WS_GATE); bf16* GM = (bf16*)(ws + WS_G); bf16* MIX = (bf16*)(ws + WS_MIX); bf16* ACT = (bf16*)(ws + WS_ACT);
    const int lo = args.ph_lo, hi = args.ph_hi;
#ifndef PH_MASK
#define PH_MASK 0x7ff
#endif
#define IN(k) (((PH_MASK >> (k)) & 1) && lo <= (k) && (k) < hi)
#define SEAM(k) do { if (IN(k) && hi > (k) + 1) xcd_barrier(bar); } while (0)
    if (hi > 1000) grid.sync();
    { volatile LAS unsigned* st = (volatile LAS unsigned*)(L + LDS_BYTES - 64); if (tid < 16) st[tid] = 0u; }
    __syncthreads();
    XcdBarrier bar = xcd_barrier_post((unsigned*)ws, (volatile LAS unsigned*)(L + LDS_BYTES - 64));
#if defined(PROBE_A)
    unsigned long long t_a = 0, t_b = 0, t_c = 0, t_d = 0;
#define STAMP(i) do { if ((i) == PROBE_A) t_a = __builtin_amdgcn_s_memrealtime(); if ((i) == PROBE_B) t_b = __builtin_amdgcn_s_memrealtime(); if ((i) == PROBE_C) t_c = __builtin_amdgcn_s_memrealtime(); if ((i) == PROBE_D) t_d = __builtin_amdgcn_s_memrealtime(); } while (0)
#else
#define STAMP(i) do {} while (0)
#endif
    STAMP(0);

    if (IN(0)) {
        LAS float* scr = (LAS float*)(L + wave * 16384);
        constexpr int I_IN = 16 * 136, I_PA = 8 * 32, I_OUT = 16 * 32, I_UP = 16 * 176, I_DN = 44 * 32;
        constexpr int NITEMS = I_IN + 2 * I_PA + I_OUT + I_UP + I_DN;
        for (int it = gw; it < NITEMS; it += NGW) {
            int r = it;
            if (r < I_IN) { const int kb = r / 136, nb = r % 136; p0_transpose_item(args.in[I_WIN], DIN, Win_t, 1024, 0, 32 * nb, scr, 64 * kb, 32 * nb, lane); continue; } r -= I_IN;
            if (r < I_PA) { const int kb = r / 32, nb = r % 32; p0_transpose_item(args.in[I_WPA], 1024, Wcat_t, 1024, 0, 32 * nb, scr, 64 * kb, 32 * nb, lane); continue; } r -= I_PA;
            if (r < I_PA) { const int kb = r / 32, nb = r % 32; p0_transpose_item(args.in[I_WPB], 1024, Wcat_t, 1024, 512, 32 * nb, scr, 64 * kb, 32 * nb, lane); continue; } r -= I_PA;
            if (r < I_OUT) { const int kb = r / 32, nb = r % 32; p0_transpose_item(args.in[I_WOUT], 1024, Wout_t, 1024, 0, 32 * nb, scr, 64 * kb, 32 * nb, lane); continue; } r -= I_OUT;
            if (r < I_UP) { const int kb = r / 176, nb = r % 176; const int n0 = 32 * nb; const int nn = n0 < DFF ? n0 : n0 - DFF;
                const int drow = 256 * (nn / 128) + (n0 < DFF ? 0 : 128) + (nn % 128);
                p0_transpose_item(args.in[I_WUP], DUP, Wup_t, 1024, 0, drow, scr, 64 * kb, n0, lane); continue; } r -= I_UP;
            { const int kb = r / 32, nb = r % 32; p0_transpose_item(args.in[I_WDN], 1024, Wdn_t, DFF, 0, 32 * nb, scr, 64 * kb, 32 * nb, lane); }
        }
        { const v4u z4 = {0u, 0u, 0u, 0u}; const int gid0 = bx * (NWAVES * 64) + tid, NT0 = G * NWAVES * 64;
          for (int i = gid0; i < (int)((size_t)M * 4 * 8 * 2 / 16); i += NT0) ((v4u*)SS1)[i] = z4;
          for (int i = gid0; i < (int)((size_t)M * 4 * 8 / 16); i += NT0) ((v4u*)SS2)[i] = z4; }
        { const int gid = bx * (NWAVES * 64) + tid;
          if (gid < 2048) { const int pos = gid >> 4, i = gid & 15; const float fr = exp2f(-(float)i * (13.287712379549449f / 16.0f)); const float ang = (float)pos * fr;
              double s, c; sincos_d((double)ang, s, c); TAB[gid] = (float)c; TAB[2048 + gid] = (float)s; } }
        const float* gw1 = args.in[I_PREMIX];
        for (int m = gw; m < M; m += NGW) {
            const f32x4* xr = (const f32x4*)xrow(xp, xs, m) + lane; f32x4 v[4]; float s2 = 0.f;
#pragma unroll
            for (int j = 0; j < 4; ++j) { v[j] = xr[64 * j]; s2 += (v[j].x * v[j].x + v[j].y * v[j].y) + (v[j].z * v[j].z + v[j].w * v[j].w); }
            const float rstd = 1.0f / sqrtf(wave_sum(s2) * (1.f / DMODEL) + EPS);
            v2u* o8 = (v2u*)(XN + (size_t)m * DMODEL) + lane;
#pragma unroll
            for (int j = 0; j < 4; ++j) { const f32x4 w = ((const f32x4*)gw1)[64 * j + lane]; v2u o; o.x = pk2(v[j].x * rstd * w.x, v[j].y * rstd * w.y); o.y = pk2(v[j].z * rstd * w.z, v[j].w * rstd * w.w); o8[64 * j] = o; }
        }
    }
    SEAM(0); STAMP(1);
    if (IN(1)) {
        pg8::Gemm g{XN, Win_t, M, DIN, DMODEL, DMODEL, DMODEL}; pg8::StaticOrder S; S.init(M, DIN, G, bx);
        pg8::EpiIn E{QA, KVA, QB, KB, VB, GATE, args.in[I_BGATE], args.in[I_QN], args.in[I_KN], TAB};
        pg8::gemm_phase<pg8::EpiIn, pg8::StaticOrder>(L, g, S, E);
    }
    SEAM(1); STAMP(2);
    if (IN(3)) {
        const attn_body::bf16* Qp = (const attn_body::bf16*)QA; const attn_body::bf16* Kp = (const attn_body::bf16*)KVA; const attn_body::bf16* Vp = (const attn_body::bf16*)(KVA + 128);
        attn_body::bf16* Op = (attn_body::bf16*)XN;
        for (int u = vcu; u < 2048; u += G) { int qb = u >> 8, bh = u & 255; if (G == 256) { bh = (vcu & ~7) + (u >> 8); qb = vcu & 7; } attn_body::attn_unit<8>((long)(bh >> 3) * 2048, 32, bh & 7, qb * 256, Qp, Kp, Vp, Op, (char*)lds); }
        for (int u = vcu; u < 512; u += G) { const int bh = (u & 255) >> 4, qb = ((u & 15) << 1) | (u >> 8); attn_body::attn_unit<8>((long)MP + (long)(bh >> 3) * 8192, 128, bh & 7, qb * 256, Qp, Kp, Vp, Op, (char*)lds); }
        __syncthreads(); STAMP(4);
        for (int id = vcu; id < 1280; id += G) nat::unit(QB, KB, VB, XN, args.in[I_RPB], L, id, tid, wave, lane);
        __syncthreads();
    }
    SEAM(3); STAMP(5);
    if (IN(4)) {
        pg8::Gemm g{XN, Wcat_t, M, DMODEL, 512, DMODEL, DMODEL}; pg8::ChainOrder S; S.base.init(M, DMODEL, G, bx); S.seg_bytes = 1024;
        pg8::EpiMerge E{GATE, GM};
        pg8::gemm_phase<pg8::EpiMerge, pg8::ChainOrder>(L, g, S, E);
    }
    SEAM(4); STAMP(6);
    if (IN(5)) {
        pg8::Gemm g{GM, Wout_t, M, DMODEL, DMODEL, DMODEL, DMODEL}; pg8::StaticOrder S; S.init(M, DMODEL, G, bx);
        pg8::EpiNorm<0> E{{(unsigned long long*)SS1}, {(unsigned long long*)SS1 + (size_t)M * 4}, xp, xs, args.out, args.in[I_POSTMIX], args.in[I_PREFFN], XN, MIX};
        pg8::gemm_phase<pg8::EpiNorm<0>, pg8::StaticOrder>(L, g, S, E);
    }
    SEAM(5); STAMP(7);
    if (IN(7)) {
        pg8::Gemm g{XN, Wup_t, M, DUP, DMODEL, DMODEL, DMODEL}; pg8::StaticOrder S; S.init(M, DUP, G, bx);
        pg8::EpiConv E{ACT, HALO, args.in[I_CW], args.in[I_CB]};
        pg8::gemm_phase<pg8::EpiConv, pg8::StaticOrder>(L, g, S, E);
    }
    SEAM(7); STAMP(9);
    if (IN(8)) {
        const float* cw = args.in[I_CW]; const float* cb = args.in[I_CB];
        const int gt = (vcu * NWAVES + wave) * 64 + lane, NGT = NGW * 64;
        for (int idx = gt; idx < 320 * 2 * (DFF / 4); idx += NGT) {
            const int q4 = idx % (DFF / 4), e = (idx / (DFF / 4)) & 1, pm = idx / (2 * (DFF / 4)); const int ca = q4 * 4;
            const int hc = (ca >> 7) * 256 + (ca & 127);
            const bool seq_first = pm < 256 ? (pm & 7) == 0 : ((pm - 256) & 31) == 0;
            const bool seq_last = pm < 256 ? (pm & 7) == 7 : ((pm - 256) & 31) == 31;
            const float* hp = HALO + (size_t)pm * 4 * 5632;
            f32x4 cv[2]; const f32x4 z = (f32x4){0.f, 0.f, 0.f, 0.f};
#pragma unroll
            for (int bj = 0; bj < 2; ++bj) { const int c = hc + bj * 128; f32x4 up, cur, dn;
                if (e == 0) { up = seq_first ? z : *(const f32x4*)(hp - 5632 + c); cur = *(const f32x4*)(hp + c); dn = *(const f32x4*)(hp + 5632 + c); }
                else { up = *(const f32x4*)(hp + 2 * 5632 + c); cur = *(const f32x4*)(hp + 3 * 5632 + c); dn = seq_last ? z : *(const f32x4*)(hp + 4 * 5632 + c); }
                const int wcx = bj * DFF + ca;
                cv[bj] = *(const f32x4*)(cw + wcx) * up + *(const f32x4*)(cw + DUP + wcx) * cur + *(const f32x4*)(cw + 2 * DUP + wcx) * dn + *(const f32x4*)(cb + wcx); }
            v2u o; o.x = pk2(pg8::gelu_tanh_f(cv[0][0]) * cv[1][0], pg8::gelu_tanh_f(cv[0][1]) * cv[1][1]); o.y = pk2(pg8::gelu_tanh_f(cv[0][2]) * cv[1][2], pg8::gelu_tanh_f(cv[0][3]) * cv[1][3]);
            *(v2u*)(ACT + (size_t)(pm * 256 + (e ? 255 : 0)) * DFF + ca) = o;
        }
    }
    SEAM(8); STAMP(10);
    if (IN(9)) {
        pg8::Gemm g{ACT, Wdn_t, M, DMODEL, DFF, DFF, DFF}; pg8::StaticOrder S; S.init(M, DMODEL, G, bx);
        pg8::EpiNorm<1> E{{(unsigned long long*)SS2}, {nullptr}, xp, xs, args.out, args.in[I_POSTFFN], nullptr, nullptr, MIX};
        pg8::gemm_phase<pg8::EpiNorm<1>, pg8::StaticOrder>(L, g, S, E);
    }
    STAMP(12);
#if defined(PROBE_A)
    __syncthreads();
    if (bx == 0 && tid == 0) { args.out[0] += (float)(t_b - t_a) * 0.01f; args.out[(size_t)MP * DMODEL] += (float)(t_d - t_c) * 0.01f; }
#endif
#undef IN
#undef SEAM
}

#ifndef MK_N_LAUNCHES
#define MK_N_LAUNCHES 1
#endif
extern "C" void kernel_launch(void* const* d_in, const int* in_sizes, int n_in, void* d_out, int out_size, void* d_ws, size_t ws_size, hipStream_t stream) {
    static int grid = 0;
    if (grid == 0) {
        if (n_in != 18 || in_sizes[0] != MP * DMODEL || out_size != M * DMODEL || ws_size < WS_END) { fprintf(stderr, "kernel_launch: unexpected shapes (n_in %d, in0 %d, out %d, ws %zu); nothing launched\n", n_in, n_in > 0 ? in_sizes[0] : -1, out_size, ws_size); grid = -1; return; }
        int dev = 0, cus = 0, per_cu = 0;
        if (hipGetDevice(&dev) != hipSuccess || hipDeviceGetAttribute(&cus, hipDeviceAttributeMultiprocessorCount, dev) != hipSuccess) { grid = -1; return; }
        if (hipFuncSetAttribute((const void*)enc_fwd, hipFuncAttributeMaxDynamicSharedMemorySize, LDS_BYTES) != hipSuccess) { fprintf(stderr, "kernel_launch: hipFuncSetAttribute failed\n"); grid = -1; return; }
        if (hipOccupancyMaxActiveBlocksPerMultiprocessor(&per_cu, (const void*)enc_fwd, NWAVES * 64, LDS_BYTES) != hipSuccess || per_cu < 1) { fprintf(stderr, "kernel_launch: occupancy query gave %d\n", per_cu); per_cu = 1; }
        (void)hipGetLastError();
        grid = cus * per_cu;
    }
    if (grid < 0) return;
    Args a{};
    for (int i = 0; i < 18; ++i) a.in[i] = (const float*)d_in[i];
    a.out = (float*)d_out; a.ws = (unsigned char*)d_ws;
#if MK_N_LAUNCHES == 1
    if (hipMemsetAsync(d_ws, 0, 16384, stream) != hipSuccess) { fprintf(stderr, "kernel_launch: memset failed\n"); return; }
    a.ph_lo = 0; a.ph_hi = NPHASE;
    void* kargs[] = {&a};
    const hipError_t e = hipLaunchCooperativeKernel((const void*)enc_fwd, dim3(grid), dim3(NWAVES * 64), kargs, LDS_BYTES, stream);
    if (e != hipSuccess) fprintf(stderr, "kernel_launch: cooperative launch failed: %s (grid %d)\n", hipGetErrorString(e), grid);
#else
    for (int p = 0; p < NPHASE; ++p) { a.ph_lo = p; a.ph_hi = p + 1; hipLaunchKernelGGL(enc_fwd, dim3(grid), dim3(NWAVES * 64), LDS_BYTES, stream, a); }
#endif
}
```
